# Optimizing an MI355X kernel written in HIP

```python
import math
import jax, jax.numpy as jnp
from jax import lax
import numpy as np

D_MODEL = 4096
BATCH = 4
SEQ = 4096
DEPTH = 1
DEC_BATCH = 1
DEC_SEQ = 16384
PAST_LEN = 128

W_A = D_MODEL // 2
DH_A = 64
H_A = W_A // (2 * DH_A)
W_B = D_MODEL // 2
N_B = 64
H_B = W_B // N_B
R_LORA = 128
C_SHIFT = 3 * W_B + 4 * R_LORA
N_IN = 3 * W_A + C_SHIFT + W_A + W_B + 2 * D_MODEL
Q_BLOCK = 128
ROPE_THETA = 10000.0
ATTN_SCALE = DH_A ** -0.5
NORM_EPS = 1e-6
SUBLN_EPS = 1e-5
LNX_EPS = 64e-5

kernel_name = "hybrid_diffattn_rwkv7_gated_encoder"


def rms_norm(x, g, eps=NORM_EPS):
    xf = x.astype(jnp.float32)
    y = xf * lax.rsqrt(jnp.mean(xf * xf, axis=-1, keepdims=True) + eps)
    return y.astype(x.dtype) * g


def lambda_init(layer_idx):
    return 0.8 - 0.6 * math.exp(-0.3 * layer_idx)


def rope(x):
    S = x.shape[1]
    half = DH_A // 2
    inv = 1.0 / (ROPE_THETA ** (jnp.arange(0, DH_A, 2, dtype=jnp.float32) / DH_A))
    ang = jnp.arange(S, dtype=jnp.float32)[:, None] * inv[None, :]
    cos = jnp.cos(ang)[None, :, None, None, :]
    sin = jnp.sin(ang)[None, :, None, None, :]
    xf = x.astype(jnp.float32)
    x1, x2 = xf[..., :half], xf[..., half:]
    return jnp.concatenate([x1 * cos - x2 * sin, x2 * cos + x1 * sin], axis=-1).astype(x.dtype)


def diff_attention(q, k, v, lam, subln_g, lam_init):
    B, S = q.shape[0], q.shape[1]
    nb = S // Q_BLOCK
    qb = q.reshape(B, nb, Q_BLOCK, H_A, 2, DH_A).swapaxes(0, 1)

    def block(qblk):
        s = jnp.einsum('bqhcd,bkhcd->bhcqk', qblk, k,
                       preferred_element_type=jnp.float32) * ATTN_SCALE
        pr = jax.nn.softmax(s, axis=-1)
        att = pr[:, :, 0] - lam * pr[:, :, 1]
        return jnp.einsum('bhqk,bkhe->bqhe', att.astype(v.dtype), v)

    o = lax.map(block, qb).swapaxes(0, 1).reshape(B, S, H_A, 2 * DH_A)
    o = rms_norm(o, subln_g, SUBLN_EPS) * (1.0 - lam_init)
    return o.reshape(B, S, W_A)


def centered_shift(p, mu_prev, mu_next):
    prev = jnp.pad(p[:, :-1], ((0, 0), (1, 0), (0, 0)))
    nxt = jnp.pad(p[:, 1:], ((0, 0), (0, 1), (0, 0)))
    return p + mu_prev * (prev - p) + mu_next * (nxt - p)


def wkv7_scan(r, w, k, v, kk, b, reverse):
    B, S = r.shape[0], r.shape[1]
    xs = tuple(t.astype(jnp.float32).reshape(B, S, H_B, N_B).swapaxes(0, 1)
               for t in (r, w, k, v, kk, b))

    def step(st, inp):
        r_t, w_t, k_t, v_t, kk_t, b_t = inp
        sa = jnp.einsum('bhij,bhj->bhi', st, -kk_t)
        st = st * w_t[:, :, None, :] + sa[..., None] * b_t[:, :, None, :] \
            + v_t[..., None] * k_t[:, :, None, :]
        y = jnp.einsum('bhij,bhj->bhi', st, r_t)
        return st, y

    st0 = jnp.zeros((B, H_B, N_B, N_B), jnp.float32)
    _, ys = lax.scan(step, st0, xs, reverse=reverse)
    return ys.swapaxes(0, 1)


def rwkv7_mix(slab, w0, w_lora, a0, a_lora, k_k, k_a, r_k, lnx_g, lnx_b):
    B, S = slab.shape[0], slab.shape[1]
    r = slab[..., :W_B]
    k = slab[..., W_B:2 * W_B]
    v = slab[..., 2 * W_B:3 * W_B]
    lo = slab[..., 3 * W_B:].reshape(B, S, 4, R_LORA)
    pw, pa = lo[:, :, 0:2], lo[:, :, 2:4]
    wl = (w0 + jnp.einsum('bsdr,drc->bsdc', jnp.tanh(pw), w_lora)).astype(jnp.float32)
    decay = jnp.exp(-jnp.exp(-jax.nn.softplus(-wl) - 0.5))
    a = jax.nn.sigmoid((a0 + jnp.einsum('bsdr,drc->bsdc', pa, a_lora)).astype(jnp.float32))
    kkh = (k * k_k).astype(jnp.float32).reshape(B, S, H_B, N_B)
    kkh = kkh / jnp.maximum(jnp.sqrt(jnp.sum(kkh * kkh, axis=-1, keepdims=True)), 1e-12)
    kk = kkh.reshape(B, S, W_B)
    kdir = k[:, :, None, :].astype(jnp.float32) * (1.0 + (a - 1.0) * k_a)
    bdir = kk[:, :, None, :] * a
    y = wkv7_scan(r, decay[:, :, 0], kdir[:, :, 0], v, kk, bdir[:, :, 0], reverse=False) \
        + wkv7_scan(r, decay[:, :, 1], kdir[:, :, 1], v, kk, bdir[:, :, 1], reverse=True)
    mu = jnp.mean(y, axis=-1, keepdims=True)
    var = jnp.mean(jnp.square(y - mu), axis=-1, keepdims=True)
    y = ((y - mu) * lax.rsqrt(var + LNX_EPS)).reshape(B, S, W_B) * lnx_g + lnx_b
    rh = r.astype(jnp.float32).reshape(B, S, 1, H_B, N_B)
    bonus_w = jnp.sum(rh * kdir.reshape(B, S, 2, H_B, N_B) * r_k, axis=(2, 4))
    bonus = bonus_w[..., None] * v.astype(jnp.float32).reshape(B, S, H_B, N_B)
    return (y + bonus.reshape(B, S, W_B)).astype(slab.dtype)


def mixer_layer(x, lam_init, norm_g, w_in, mu_prev, mu_next, lam_q1, lam_k1, lam_q2, lam_k2,
                subln_g, w0, w_lora, a0, a_lora, k_k, k_a, r_k, lnx_g, lnx_b, w_oA, w_oB, w_out):
    B, S, _ = x.shape
    h = rms_norm(x, norm_g)
    p = jnp.einsum('bsd,dn->bsn', h, w_in)
    q = p[..., 0:W_A].reshape(B, S, H_A, 2, DH_A)
    k = p[..., W_A:2 * W_A].reshape(B, S, H_A, 2, DH_A)
    v = p[..., 2 * W_A:3 * W_A].reshape(B, S, H_A, 2 * DH_A)
    slab = centered_shift(p[..., 3 * W_A:3 * W_A + C_SHIFT], mu_prev, mu_next)
    off = 3 * W_A + C_SHIFT
    z_a = p[..., off:off + W_A]
    z_b = p[..., off + W_A:off + W_A + W_B]
    off2 = off + W_A + W_B
    g_a = p[..., off2:off2 + D_MODEL]
    g_b = p[..., off2 + D_MODEL:off2 + 2 * D_MODEL]

    lam = (jnp.exp(jnp.sum(lam_q1.astype(jnp.float32) * lam_k1.astype(jnp.float32)))
           - jnp.exp(jnp.sum(lam_q2.astype(jnp.float32) * lam_k2.astype(jnp.float32)))
           + lam_init)
    y_a = diff_attention(rope(q), rope(k), v, lam, subln_g, lam_init)
    y_b = rwkv7_mix(slab, w0, w_lora, a0, a_lora, k_k, k_a, r_k, lnx_g, lnx_b)

    o_a = jnp.einsum('bsc,cd->bsd', y_a * jax.nn.silu(z_a), w_oA)
    o_b = jnp.einsum('bsc,cd->bsd', y_b * jax.nn.silu(z_b), w_oB)
    m = jax.nn.sigmoid(g_a) * o_a + jax.nn.sigmoid(g_b) * o_b
    return x + jnp.einsum('bsd,de->bse', m, w_out)


def setup_inputs(seed: int = 0) -> dict:
    key = jax.random.key(seed)
    ks = jax.random.split(key, 24)
    f32 = jnp.float32

    def nrm(k, shape, s):
        return jax.random.normal(k, shape, f32) * s

    return {
        "x_prompt": nrm(ks[0], (BATCH, SEQ, D_MODEL), 1.0),
        "x_sample": nrm(ks[1], (DEC_BATCH, DEC_SEQ, D_MODEL), 1.0),
        "norm_g": 1.0 + nrm(ks[2], (DEPTH, D_MODEL), 0.05),
        "w_in": nrm(ks[3], (DEPTH, D_MODEL, N_IN), D_MODEL ** -0.5),
        "mu_prev": jax.random.uniform(ks[4], (DEPTH, C_SHIFT), f32, 0.0, 0.5),
        "mu_next": jax.random.uniform(ks[5], (DEPTH, C_SHIFT), f32, 0.0, 0.5),
        "lam_q1": nrm(ks[6], (DEPTH, DH_A), 0.1),
        "lam_k1": nrm(ks[7], (DEPTH, DH_A), 0.1),
        "lam_q2": nrm(ks[8], (DEPTH, DH_A), 0.1),
        "lam_k2": nrm(ks[9], (DEPTH, DH_A), 0.1),
        "subln_g": 1.0 + nrm(ks[10], (DEPTH, 2 * DH_A), 0.05),
        "w0": jax.random.uniform(ks[11], (DEPTH, 2, W_B), f32, -4.0, 0.0),
        "w_lora": nrm(ks[12], (DEPTH, 2, R_LORA, W_B), 0.5 * R_LORA ** -0.5),
        "a0": nrm(ks[13], (DEPTH, 2, W_B), 0.5),
        "a_lora": nrm(ks[14], (DEPTH, 2, R_LORA, W_B), 0.5 * R_LORA ** -0.5),
        "k_k": 0.85 + nrm(ks[15], (DEPTH, W_B), 0.05),
        "k_a": 1.0 + nrm(ks[16], (DEPTH, W_B), 0.05),
        "r_k": nrm(ks[17], (DEPTH, H_B, N_B), 0.1),
        "lnx_g": 1.0 + nrm(ks[18], (DEPTH, W_B), 0.05),
        "lnx_b": nrm(ks[19], (DEPTH, W_B), 0.02),
        "w_oA": nrm(ks[20], (DEPTH, W_A, D_MODEL), W_A ** -0.5),
        "w_oB": nrm(ks[21], (DEPTH, W_B, D_MODEL), W_B ** -0.5),
        "w_out": nrm(ks[22], (DEPTH, D_MODEL, D_MODEL), D_MODEL ** -0.5),
        "final_g": 1.0 + nrm(ks[23], (D_MODEL,), 0.05),
    }


def reference(x_prompt, x_sample, norm_g, w_in, mu_prev, mu_next, lam_q1, lam_k1, lam_q2, lam_k2,
              subln_g, w0, w_lora, a0, a_lora, k_k, k_a, r_k, lnx_g, lnx_b, w_oA, w_oB, w_out,
              final_g):
    def trunk(x):
        for l in range(DEPTH):
            x = mixer_layer(x, lambda_init(l), norm_g[l], w_in[l], mu_prev[l], mu_next[l],
                            lam_q1[l], lam_k1[l], lam_q2[l], lam_k2[l], subln_g[l],
                            w0[l], w_lora[l], a0[l], a_lora[l], k_k[l], k_a[l], r_k[l],
                            lnx_g[l], lnx_b[l], w_oA[l], w_oB[l], w_out[l])
        return rms_norm(x, final_g)

    y_prompt = trunk(x_prompt)
    y_sample = trunk(x_sample)
    return (y_prompt, y_sample)
```

```cpp
#include <hip/hip_runtime.h>
#include <cstdio>
#include <cstdint>

#ifndef MK_SINGLE
#define MK_SINGLE 0
#endif

template <int K> __device__ __forceinline__ float shx(float v) {
    if constexpr (K == 32) { const unsigned u = __builtin_bit_cast(unsigned, v); auto rr = __builtin_amdgcn_permlane32_swap(u, u, false, false);
        return __builtin_bit_cast(float, (threadIdx.x & 32) ? rr[0] : rr[1]); }
    else return __builtin_bit_cast(float, __builtin_amdgcn_ds_swizzle(__builtin_bit_cast(int, v), (K << 10) | 0x1f));
}
namespace pg8 {
#define PG8_LAS __attribute__((address_space(3)))
typedef unsigned short bf16_t;
typedef short bf16x8 __attribute__((ext_vector_type(8)));
typedef float f32x4 __attribute__((ext_vector_type(4)));
typedef unsigned u32x4 __attribute__((ext_vector_type(4)));
constexpr int BM = 256, BK = 64, HALF = 128, HTB = HALF * BK * 2  , STAGE_BYTES = 8 * HTB, NXCD = 8, WGM = 8;

__host__ __device__ __forceinline__ int lds_byte(int r, int c) { const int st = (r >> 4) * 2 + (c >> 5), rr = r & 15, cc = c & 31, ob = rr * 64 + cc * 2; return st * 1024 + (ob ^ (((ob >> 9) & 1) << 5)); }
__host__ __device__ __forceinline__ void stage_rc(int b, int& R, int& C) { const int st = b / 1024, sb = b % 1024, swz = sb ^ (((sb >> 9) & 1) << 5); R = (st >> 1) * 16 + swz / 64; C = (st & 1) * 32 + (swz % 64) / 2; }
__host__ __device__ __forceinline__ int perm32(int rho) { const int n = rho >> 4, i = rho & 15; return 8 * (i >> 2) + 4 * n + (i & 3); }

struct Unit { int pm, pn; };
struct Gemm { const bf16_t* A; const bf16_t* Bt; int M, N, K; };

struct StaticOrder {
    int nM, nN, nwg, G, c;
    __host__ __device__ void init(int M, int N, int G_, int c_) { nM = M / BM; nN = N / BM; nwg = nM * nN; G = G_; c = c_; }
    __host__ __device__ bool next(int i, Unit& u) const {
        const long L = (long)i * G + c; if (L >= nwg) return false;
        int wgid = (int)L; { const int q = nwg / NXCD, r = nwg % NXCD, xcd = wgid % NXCD, off = wgid / NXCD; wgid = (xcd < r ? xcd * (q + 1) : r * (q + 1) + (xcd - r) * q) + off; }
        const int nig = WGM * nN, gid = wgid / nig, fm = gid * WGM, gsz = (nM - fm) < WGM ? (nM - fm) : WGM;
        u.pm = fm + ((wgid % nig) % gsz); u.pn = (wgid % nig) / gsz; return true;
    }
    __device__ __forceinline__ void a_ready(const Unit&) const {}
    __device__ __forceinline__ void done(const Unit&) const {}
};
typedef float f32x2_t __attribute__((ext_vector_type(2))); typedef __bf16 bf16x2_t __attribute__((ext_vector_type(2)));
__device__ __forceinline__ unsigned cvt_pk_bf16(float lo, float hi) { f32x2_t v = {lo, hi}; bf16x2_t b = __builtin_convertvector(v, bf16x2_t); return __builtin_bit_cast(unsigned, b); }
__device__ __forceinline__ float bflo(unsigned w) { return __builtin_bit_cast(float, w << 16); }
__device__ __forceinline__ float bfhi(unsigned w) { return __builtin_bit_cast(float, w & 0xffff0000u); }
__device__ __forceinline__ float fast_sigmoid(float x) { return __builtin_amdgcn_rcpf(1.f + __builtin_amdgcn_exp2f(-1.4426950408889634f * x)); }
constexpr float C2 = 0.125f * 1.4426950408889634f;
struct EpiInA {
    static constexpr bool PERM = true, AFTER_DRAIN = false;
    bf16_t *Q, *K, *V, *SL; const float* rope;
    __device__ __forceinline__ void operator()(const f32x4 (&acc)[2][2][4][2], const Unit& u, int wr, int wc, int fr, int fq) const {
        const int pn = u.pn, row0 = u.pm * BM + wr * 64 + fr;
        if (pn < 16) {
            bf16_t* base = pn < 8 ? Q : K; const float sc = pn < 8 ? C2 : 1.f; const int colt = (pn & 7) * BM + wc * 32 + 8 * fq;
#pragma unroll
            for (int ai = 0; ai < 2; ++ai)
#pragma unroll
                for (int m = 0; m < 4; ++m) { const int row = row0 + ai * HALF + m * 16; const int pos = row < 16384 ? (row & 4095) : (row - 16384);
                    bf16_t* rowp = base + (size_t)row * 2048 + colt;
#pragma unroll
                    for (int bj = 0; bj < 2; ++bj) { const int i0 = ((colt + bj * HALF) & 63) >> 1;
                        const f32x4* tp = (const f32x4*)(rope + ((size_t)pos * 32 + i0) * 2); const f32x4 t0 = tp[0], t1 = tp[1];
                        const f32x4 v0 = acc[ai][bj][m][0], v1 = acc[ai][bj][m][1]; u32x4 w;
                        w.x = cvt_pk_bf16((v0[0] * t0[0] - v0[1] * t0[1]) * sc, (v0[1] * t0[0] + v0[0] * t0[1]) * sc);
                        w.y = cvt_pk_bf16((v0[2] * t0[2] - v0[3] * t0[3]) * sc, (v0[3] * t0[2] + v0[2] * t0[3]) * sc);
                        w.z = cvt_pk_bf16((v1[0] * t1[0] - v1[1] * t1[1]) * sc, (v1[1] * t1[0] + v1[0] * t1[1]) * sc);
                        w.w = cvt_pk_bf16((v1[2] * t1[2] - v1[3] * t1[3]) * sc, (v1[3] * t1[2] + v1[2] * t1[3]) * sc);
                        *(u32x4*)(rowp + bj * HALF) = w; __builtin_amdgcn_sched_barrier(0); } }
        } else {
            bf16_t* base; int ldc, colt;
            if (pn < 24) { base = V; ldc = 2048; colt = (pn - 16) * BM; } else { base = SL; ldc = 6656; colt = (pn - 24) * BM; }
            colt += wc * 32 + 8 * fq;
#pragma unroll
            for (int ai = 0; ai < 2; ++ai)
#pragma unroll
                for (int m = 0; m < 4; ++m) { bf16_t* rowp = base + (size_t)(row0 + ai * HALF + m * 16) * ldc + colt;
#pragma unroll
                    for (int bj = 0; bj < 2; ++bj) { const f32x4 v0 = acc[ai][bj][m][0], v1 = acc[ai][bj][m][1]; u32x4 w;
                        w.x = cvt_pk_bf16(v0[0], v0[1]); w.y = cvt_pk_bf16(v0[2], v0[3]); w.z = cvt_pk_bf16(v1[0], v1[1]); w.w = cvt_pk_bf16(v1[2], v1[3]);
                        *(u32x4*)(rowp + bj * HALF) = w; __builtin_amdgcn_sched_barrier(0); } }
        }
    }
};
struct EpiZ {
    static constexpr bool PERM = true, AFTER_DRAIN = false;
    bf16_t *YA, *YB;
    __device__ __forceinline__ void operator()(const f32x4 (&acc)[2][2][4][2], const Unit& u, int wr, int wc, int fr, int fq) const {
        const int pn = u.pn, row0 = u.pm * BM + wr * 64 + fr;
        bf16_t* base = pn < 8 ? YA : YB; const int colt = (pn & 7) * BM + wc * 32 + 8 * fq;
#pragma unroll
        for (int ai = 0; ai < 2; ++ai)
#pragma unroll
            for (int m = 0; m < 4; ++m) { bf16_t* rowp = base + (size_t)(row0 + ai * HALF + m * 16) * 2048 + colt;
#pragma unroll
                for (int bj = 0; bj < 2; ++bj) { const f32x4 v0 = acc[ai][bj][m][0], v1 = acc[ai][bj][m][1]; const u32x4 y = *(const u32x4*)(rowp + bj * HALF); u32x4 w;
                    w.x = cvt_pk_bf16(bflo(y.x) * v0[0] * fast_sigmoid(v0[0]), bfhi(y.x) * v0[1] * fast_sigmoid(v0[1]));
                    w.y = cvt_pk_bf16(bflo(y.y) * v0[2] * fast_sigmoid(v0[2]), bfhi(y.y) * v0[3] * fast_sigmoid(v0[3]));
                    w.z = cvt_pk_bf16(bflo(y.z) * v1[0] * fast_sigmoid(v1[0]), bfhi(y.z) * v1[1] * fast_sigmoid(v1[1]));
                    w.w = cvt_pk_bf16(bflo(y.w) * v1[2] * fast_sigmoid(v1[2]), bfhi(y.w) * v1[3] * fast_sigmoid(v1[3]));
                    *(u32x4*)(rowp + bj * HALF) = w; __builtin_amdgcn_sched_barrier(0); } }
    }
};
struct EpiG {
    static constexpr bool PERM = true, AFTER_DRAIN = false;
    bf16_t* G;
    __device__ __forceinline__ void operator()(const f32x4 (&acc)[2][2][4][2], const Unit& u, int wr, int wc, int fr, int fq) const {
        const int row0 = u.pm * BM + wr * 64 + fr, colt = u.pn * BM + wc * 32 + 8 * fq;
#pragma unroll
        for (int ai = 0; ai < 2; ++ai)
#pragma unroll
            for (int m = 0; m < 4; ++m) { bf16_t* rowp = G + (size_t)(row0 + ai * HALF + m * 16) * 8192 + colt;
#pragma unroll
                for (int bj = 0; bj < 2; ++bj) { const f32x4 v0 = acc[ai][bj][m][0], v1 = acc[ai][bj][m][1]; u32x4 w;
                    w.x = cvt_pk_bf16(fast_sigmoid(v0[0]), fast_sigmoid(v0[1])); w.y = cvt_pk_bf16(fast_sigmoid(v0[2]), fast_sigmoid(v0[3]));
                    w.z = cvt_pk_bf16(fast_sigmoid(v1[0]), fast_sigmoid(v1[1])); w.w = cvt_pk_bf16(fast_sigmoid(v1[2]), fast_sigmoid(v1[3]));
                    *(u32x4*)(rowp + bj * HALF) = w; __builtin_amdgcn_sched_barrier(0); } }
    }
};
template <bool SECOND> struct EpiM {
    static constexpr bool PERM = true, AFTER_DRAIN = false;
    bf16_t* Mb; const bf16_t* G;
    __device__ __forceinline__ void operator()(const f32x4 (&acc)[2][2][4][2], const Unit& u, int wr, int wc, int fr, int fq) const {
        const int row0 = u.pm * BM + wr * 64 + fr, colt = u.pn * BM + wc * 32 + 8 * fq;
#pragma unroll
        for (int ai = 0; ai < 2; ++ai)
#pragma unroll
            for (int m = 0; m < 4; ++m) { const size_t row = (size_t)(row0 + ai * HALF + m * 16); bf16_t* rowp = Mb + row * 4096 + colt; const bf16_t* gp = G + row * 8192 + (SECOND ? 4096 : 0) + colt;
#pragma unroll
                for (int bj = 0; bj < 2; ++bj) { const f32x4 v0 = acc[ai][bj][m][0], v1 = acc[ai][bj][m][1]; const u32x4 g = *(const u32x4*)(gp + bj * HALF);
                    float o[8] = {bflo(g.x) * v0[0], bfhi(g.x) * v0[1], bflo(g.y) * v0[2], bfhi(g.y) * v0[3], bflo(g.z) * v1[0], bfhi(g.z) * v1[1], bflo(g.w) * v1[2], bfhi(g.w) * v1[3]};
                    if (SECOND) { const u32x4 p = *(const u32x4*)(rowp + bj * HALF);
                        o[0] += bflo(p.x); o[1] += bfhi(p.x); o[2] += bflo(p.y); o[3] += bfhi(p.y); o[4] += bflo(p.z); o[5] += bfhi(p.z); o[6] += bflo(p.w); o[7] += bfhi(p.w); }
                    u32x4 w; w.x = cvt_pk_bf16(o[0], o[1]); w.y = cvt_pk_bf16(o[2], o[3]); w.z = cvt_pk_bf16(o[4], o[5]); w.w = cvt_pk_bf16(o[6], o[7]);
                    *(u32x4*)(rowp + bj * HALF) = w; __builtin_amdgcn_sched_barrier(0); } }
    }
};
struct EpiOut {
    static constexpr bool PERM = true, AFTER_DRAIN = false;
    const float *xp, *xs; float* out; float* part;
    __device__ __forceinline__ void operator()(const f32x4 (&acc)[2][2][4][2], const Unit& u, int wr, int wc, int fr, int fq) const {
        const int row0 = u.pm * BM + wr * 64 + fr, colt = u.pn * BM + wc * 32 + 8 * fq;
#pragma unroll
        for (int ai = 0; ai < 2; ++ai)
#pragma unroll
            for (int m = 0; m < 4; ++m) { const int row = row0 + ai * HALF + m * 16;
                const float* xr = (row < 16384 ? xp + (size_t)row * 4096 : xs + (size_t)(row - 16384) * 4096) + colt; float* orow = out + (size_t)row * 4096 + colt; float ss = 0.f;
#pragma unroll
                for (int bj = 0; bj < 2; ++bj) { const f32x4 a0 = *(const f32x4*)(xr + bj * HALF), a1 = *(const f32x4*)(xr + bj * HALF + 4);
                    const f32x4 o0 = a0 + acc[ai][bj][m][0], o1 = a1 + acc[ai][bj][m][1];
                    ss += (o0[0] * o0[0] + o0[1] * o0[1]) + (o0[2] * o0[2] + o0[3] * o0[3]) + (o1[0] * o1[0] + o1[1] * o1[1]) + (o1[2] * o1[2] + o1[3] * o1[3]);
                    *(f32x4*)(orow + bj * HALF) = o0; *(f32x4*)(orow + bj * HALF + 4) = o1; }
                ss += shx<16>(ss); ss += shx<32>(ss);
                if (fq == 0) part[(size_t)row * 64 + u.pn * 4 + wc] = ss; }
    }
};
template <class Epi, class Sched, bool ALIGN_EPI = false, bool SP2 = false>
__device__ __forceinline__ void gemm_phase(PG8_LAS unsigned char* lds, const Gemm g, const Sched& S, const Epi& E) {
    const int tid = threadIdx.x, wid = __builtin_amdgcn_readfirstlane(tid >> 6), lane = tid & 63, wr = wid >> 2, wc = wid & 3, fr = lane & 15, fq = lane >> 4;
    const int K = g.K, nt = K / BK;
    unsigned voffA[2], voffB[2];
#pragma unroll
    for (int i = 0; i < 2; ++i) { int R, C; stage_rc(tid * 16 + i * 8192, R, C); const int Rb = Epi::PERM ? ((R & ~31) + perm32(R & 31)) : R;
        voffA[i] = (unsigned)(R * K + C) * 2u; voffB[i] = (unsigned)(Rb * K + C) * 2u; }
    const size_t kstep = (size_t)(BK * 2);
    const size_t hstep = (size_t)HALF * K * 2;
    const size_t tstep = 2 * hstep;
    const unsigned ldsw = (unsigned)wid * 1024u;
    const int aoff = lds_byte(wr * 64 + fr, fq * 8), boff = lds_byte(wc * 32 + fr, fq * 8);
#define PG8_SA(b, h) (((b) * 2 + (h)) * HTB)
#define PG8_SB(b, h) ((4 + (b) * 2 + (h)) * HTB)
#define PG8_STAGE(bufoff, gbase, voff) do { _Pragma("unroll") for (int _i = 0; _i < 2; ++_i) \
        __builtin_amdgcn_global_load_lds((const unsigned*)((const char*)(gbase) + (voff)[_i]), (PG8_LAS unsigned*)(lds + (bufoff) + ldsw + _i * 8192), 16, 0, 0); } while (0)
#define PG8_LDA(dst, b, h) do { _Pragma("unroll") for (int m = 0; m < 4; ++m) _Pragma("unroll") for (int k = 0; k < 2; ++k) dst[m][k] = *(const PG8_LAS bf16x8*)(lds + PG8_SA(b, h) + aoff + m * 2048 + k * 1024); } while (0)
#define PG8_LDB(dst, b, h) do { _Pragma("unroll") for (int n = 0; n < 2; ++n) _Pragma("unroll") for (int k = 0; k < 2; ++k) dst[n][k] = *(const PG8_LAS bf16x8*)(lds + PG8_SB(b, h) + boff + n * 2048 + k * 1024); } while (0)
#define PG8_MMA(ai, bj, At, Bt) do { __builtin_amdgcn_s_setprio(1); _Pragma("unroll") for (int m = 0; m < 4; ++m) _Pragma("unroll") for (int n = 0; n < 2; ++n) _Pragma("unroll") for (int k = 0; k < 2; ++k) \
        acc[ai][bj][m][n] = __builtin_amdgcn_mfma_f32_16x16x32_bf16(Bt[n][k], At[m][k], acc[ai][bj][m][n], 0, 0, 0); __builtin_amdgcn_s_setprio(0); } while (0)
#define PG8_WAIT_V(n) asm volatile("s_waitcnt vmcnt(" #n ")" ::: "memory")
#define PG8_WAIT_L(n) asm volatile("s_waitcnt lgkmcnt(" #n ")" ::: "memory")
#define PG8_BAR __builtin_amdgcn_s_barrier()
#define PG8_SCHED __builtin_amdgcn_sched_barrier(0)
    Unit cur, nxt; int ui = 0;
    if (!S.next(0, cur)) return;
    f32x4 acc[2][2][4][2];
#pragma unroll
    for (int a = 0; a < 2; ++a)
#pragma unroll
        for (int b = 0; b < 2; ++b)
#pragma unroll
            for (int m = 0; m < 4; ++m)
#pragma unroll
                for (int n = 0; n < 2; ++n) acc[a][b][m][n] = (f32x4){0.f, 0.f, 0.f, 0.f};
    bf16x8 At[4][2], B0[2][2], B1[2][2];
    const char* cA = (const char*)g.A + (size_t)cur.pm * tstep; const char* cB = (const char*)g.Bt + (size_t)cur.pn * tstep;
    S.a_ready(cur);
    if constexpr (SP2) {
        PG8_STAGE(PG8_SB(0, 0), cB, voffB); PG8_STAGE(PG8_SB(0, 1), cB + hstep, voffB); PG8_STAGE(PG8_SA(0, 0), cA, voffA); PG8_STAGE(PG8_SA(0, 1), cA + hstep, voffA);
        if (wr == 1) PG8_BAR;
        PG8_WAIT_V(2); PG8_BAR;
        PG8_STAGE(PG8_SB(1, 0), cB + kstep, voffB); PG8_STAGE(PG8_SA(1, 0), cA + kstep, voffA); PG8_STAGE(PG8_SB(1, 1), cB + hstep + kstep, voffB);
        PG8_WAIT_V(6); PG8_BAR;
    } else {
        PG8_STAGE(PG8_SB(0, 0), cB, voffB); PG8_STAGE(PG8_SA(0, 0), cA, voffA); PG8_STAGE(PG8_SB(0, 1), cB + hstep, voffB); PG8_STAGE(PG8_SA(0, 1), cA + hstep, voffA);
        if (wr == 1) PG8_BAR;
        PG8_WAIT_V(4); PG8_BAR;
        PG8_STAGE(PG8_SB(1, 0), cB + kstep, voffB); PG8_STAGE(PG8_SA(1, 0), cA + kstep, voffA); PG8_STAGE(PG8_SB(1, 1), cB + hstep + kstep, voffB);
        PG8_WAIT_V(6); PG8_BAR;
    }
    for (;;) {
        const bool has_next = S.next(ui + 1, nxt);
        const char* nA = has_next ? (const char*)g.A + (size_t)nxt.pm * tstep : cA; const char* nB = has_next ? (const char*)g.Bt + (size_t)nxt.pn * tstep : cB;
        for (int t = 0; t < nt; t += 2) {
            const bool last = (t == nt - 2);
            const char* a1 = cA + (size_t)(t + 1) * kstep;
            const char* a2 = last ? nA : cA + (size_t)(t + 2) * kstep; const char* b2 = last ? nB : cB + (size_t)(t + 2) * kstep;
            const char* a3 = a2 + kstep; const char* b3 = b2 + kstep;
            if (last && has_next) S.a_ready(nxt);
            if constexpr (SP2) {
            PG8_LDB(B0, 0, 0); PG8_LDB(B1, 0, 1); PG8_SCHED; PG8_LDA(At, 0, 0); PG8_STAGE(PG8_SA(1, 1), a1 + hstep, voffA);
            PG8_WAIT_V(8); PG8_WAIT_L(0); PG8_BAR; PG8_MMA(0, 0, At, B0); PG8_MMA(0, 1, At, B1); PG8_BAR; PG8_SCHED;
            PG8_LDA(At, 0, 1); PG8_STAGE(PG8_SB(0, 0), b2, voffB); PG8_STAGE(PG8_SB(0, 1), b2 + hstep, voffB); PG8_STAGE(PG8_SA(0, 0), a2, voffA);
            PG8_WAIT_V(8); PG8_WAIT_L(0); PG8_BAR; PG8_MMA(1, 0, At, B0); PG8_MMA(1, 1, At, B1); PG8_BAR; PG8_SCHED;
            PG8_LDB(B0, 1, 0); PG8_LDB(B1, 1, 1); PG8_SCHED; PG8_LDA(At, 1, 0); PG8_STAGE(PG8_SA(0, 1), a2 + hstep, voffA);
            PG8_WAIT_V(8); PG8_WAIT_L(0); PG8_BAR; PG8_MMA(0, 0, At, B0); PG8_MMA(0, 1, At, B1); PG8_BAR; PG8_SCHED;
            PG8_LDA(At, 1, 1); PG8_STAGE(PG8_SB(1, 0), b3, voffB); PG8_STAGE(PG8_SB(1, 1), b3 + hstep, voffB); PG8_STAGE(PG8_SA(1, 0), a3, voffA);
            PG8_WAIT_V(8); PG8_WAIT_L(0); PG8_BAR; PG8_MMA(1, 0, At, B0); PG8_MMA(1, 1, At, B1); PG8_BAR; PG8_SCHED;
            } else {
            PG8_LDB(B0, 0, 0); PG8_SCHED; PG8_LDA(At, 0, 0); PG8_STAGE(PG8_SA(1, 1), a1 + hstep, voffA);
            PG8_WAIT_L(8); PG8_BAR; PG8_WAIT_L(0); PG8_MMA(0, 0, At, B0); PG8_BAR; PG8_SCHED;
            PG8_LDB(B1, 0, 1); PG8_STAGE(PG8_SB(0, 0), b2, voffB);
            PG8_BAR; PG8_WAIT_L(0); PG8_MMA(0, 1, At, B1); PG8_BAR;
            PG8_LDA(At, 0, 1); PG8_STAGE(PG8_SA(0, 0), a2, voffA);
            PG8_BAR; PG8_WAIT_L(0); PG8_MMA(1, 0, At, B0); PG8_BAR; PG8_SCHED;
            PG8_STAGE(PG8_SB(0, 1), b2 + hstep, voffB);
            PG8_WAIT_V(6); PG8_BAR; PG8_MMA(1, 1, At, B1); PG8_BAR;
            PG8_LDB(B0, 1, 0); PG8_SCHED; PG8_LDA(At, 1, 0); PG8_STAGE(PG8_SA(0, 1), a2 + hstep, voffA);
            PG8_WAIT_L(8); PG8_BAR; PG8_WAIT_L(0); PG8_MMA(0, 0, At, B0); PG8_BAR; PG8_SCHED;
            PG8_LDB(B1, 1, 1); PG8_STAGE(PG8_SB(1, 0), b3, voffB);
            PG8_BAR; PG8_WAIT_L(0); PG8_MMA(0, 1, At, B1); PG8_BAR;
            PG8_LDA(At, 1, 1); PG8_STAGE(PG8_SA(1, 0), a3, voffA);
            PG8_BAR; PG8_WAIT_L(0); PG8_MMA(1, 0, At, B0); PG8_BAR; PG8_SCHED;
            PG8_STAGE(PG8_SB(1, 1), b3 + hstep, voffB);
            PG8_WAIT_V(6); PG8_BAR; PG8_MMA(1, 1, At, B1); PG8_BAR;
            }
        }
        if constexpr (ALIGN_EPI) { if (wr == 0) PG8_BAR; }
        if constexpr (!Epi::AFTER_DRAIN) { E(acc, cur, wr, wc, fr, fq); S.done(cur); }
        if (!has_next) break;
#pragma unroll
        for (int a = 0; a < 2; ++a)
#pragma unroll
            for (int b = 0; b < 2; ++b)
#pragma unroll
                for (int m = 0; m < 4; ++m)
#pragma unroll
                    for (int n = 0; n < 2; ++n) acc[a][b][m][n] = (f32x4){0.f, 0.f, 0.f, 0.f};
        cur = nxt; cA = nA; cB = nB; ++ui;
        if constexpr (ALIGN_EPI) { if (wr == 1) PG8_BAR; }
    }
    PG8_WAIT_V(0);
    if constexpr (!ALIGN_EPI) { if (wr == 0) PG8_BAR; }
    PG8_BAR;
    if constexpr (Epi::AFTER_DRAIN) { E.fused(acc, cur, wr, wc, fr, fq, lds, wid, lane); S.done(cur); }
#undef PG8_SA
#undef PG8_SB
#undef PG8_STAGE
#undef PG8_LDA
#undef PG8_LDB
#undef PG8_MMA
#undef PG8_WAIT_V
#undef PG8_WAIT_L
#undef PG8_BAR
#undef PG8_SCHED
}
}
typedef unsigned u32x4 __attribute__((ext_vector_type(4)));
#define GAS __attribute__((address_space(1)))
#define LAS __attribute__((address_space(3)))
typedef unsigned short bf16;
typedef unsigned v4u __attribute__((ext_vector_type(4)));
typedef float f32x4 __attribute__((ext_vector_type(4)));
typedef short bf16x8 __attribute__((ext_vector_type(8)));
typedef GAS unsigned gu32;
typedef GAS unsigned long long gu64;
#define RLX_AGENT __ATOMIC_RELAXED, __HIP_MEMORY_SCOPE_AGENT
#define LDS_WAIT() asm volatile("s_waitcnt lgkmcnt(0)" ::: "memory")
#define VM_WAIT() asm volatile("s_waitcnt vmcnt(0)" ::: "memory")
__device__ __forceinline__ unsigned long long rt() { return __builtin_amdgcn_s_memrealtime(); }
__device__ __forceinline__ unsigned f2bf(float f) { unsigned u = __builtin_bit_cast(unsigned, f); return (u + 0x7fffu + ((u >> 16) & 1u)) >> 16; }
__device__ __forceinline__ unsigned pk2(float lo, float hi) { return f2bf(lo) | (f2bf(hi) << 16); }
#define XB_TMO      128
#define XB_XCNT(j)  (256  + 64 * (j))
#define XB_XSUB(j)  (1280 + 64 * (j))
#define XB_XGEN(j)  (2304 + 64 * (j))
#define XB_TOP      3328
#define XB_TOPGEN   3392
#define XCD_BAR_WORDS 3456
#define XB_SPIN_CAP (1u << 21)

__device__ __forceinline__ unsigned xb_ld(unsigned* p)              { return __hip_atomic_load(p, __ATOMIC_RELAXED, __HIP_MEMORY_SCOPE_AGENT); }
__device__ __forceinline__ unsigned xb_add(unsigned* p, unsigned v) { return __hip_atomic_fetch_add(p, v, __ATOMIC_RELAXED, __HIP_MEMORY_SCOPE_AGENT); }
__device__ __forceinline__ unsigned xb_xcc_id() { return (unsigned)__builtin_amdgcn_s_getreg((3 << 11) | 20) & 0xFu; }
#define XB_SPIN(cond, bar) do { unsigned _sp = 0; while (cond) { __builtin_amdgcn_s_sleep(1); \
    if ((++_sp & 255u) == 0u) { if (xb_ld(&(bar)[XB_TMO])) break; if (_sp > XB_SPIN_CAP) { atomicAdd(&(bar)[XB_TMO], 1u); break; } } } } while (0)

struct XcdBarrier {
    unsigned* bar; unsigned x;
    volatile LAS unsigned* st;
};

__device__ __forceinline__ XcdBarrier xcd_barrier_post(unsigned* bar, volatile LAS unsigned* st) {
    XcdBarrier b; b.bar = bar; b.x = xb_xcc_id(); b.st = st;
    if (threadIdx.x == 0) (void)xb_add(&bar[XB_XCNT(b.x)], 1u);
    return b;
}
__device__ __forceinline__ void xcd_barrier_complete(unsigned* bar, unsigned x, unsigned& nloc, unsigned& nx) {
    const unsigned G = gridDim.x * gridDim.y * gridDim.z;
    unsigned sum, cnt, mine, sp = 0u;
    for (;;) {
        sum = 0u; cnt = 0u; mine = 0u;
#pragma unroll
        for (unsigned j = 0; j < 16; ++j) { const unsigned c = xb_ld(&bar[XB_XCNT(j)]); sum += c; cnt += (c > 0u) ? 1u : 0u; mine = (j == x) ? c : mine; }
        if (sum == G) break;
        __builtin_amdgcn_s_sleep(1);
        if ((++sp & 255u) == 0u) { if (xb_ld(&bar[XB_TMO])) break; if (sp > XB_SPIN_CAP) { atomicAdd(&bar[XB_TMO], 1u); break; } }
    }
    nloc = mine > 0u ? mine : 1u; nx = cnt > 0u ? cnt : 1u;
}

__device__ __forceinline__ void xcd_barrier(const XcdBarrier& b) {
    asm volatile("s_waitcnt vmcnt(0)" ::: "memory");
    __syncthreads();
    if (threadIdx.x == 0) {
        unsigned* bar = b.bar;
        __builtin_amdgcn_s_waitcnt(0);
        unsigned nloc = b.st[0], nx = b.st[1];
        if (nloc == 0u) { xcd_barrier_complete(bar, b.x, nloc, nx); b.st[0] = nloc; b.st[1] = nx; }
        const unsigned old = xb_add(&bar[XB_XSUB(b.x)], 1u);
        const unsigned gen = old / nloc;
        if (old + 1u == (gen + 1u) * nloc) {
            __builtin_amdgcn_fence(__ATOMIC_RELEASE, "agent");
            asm volatile("s_waitcnt vmcnt(0)" ::: "memory");
            const unsigned og = xb_add(&bar[XB_TOP], 1u);
            const unsigned tg = og / nx;
            if (og + 1u == (tg + 1u) * nx) xb_add(&bar[XB_TOPGEN], 1u);
            else XB_SPIN(xb_ld(&bar[XB_TOPGEN]) == tg, bar);
            __builtin_amdgcn_fence(__ATOMIC_ACQUIRE, "agent");
            xb_add(&bar[XB_XGEN(b.x)], 1u);
            asm volatile("s_waitcnt vmcnt(0)" ::: "memory");
        } else {
            XB_SPIN(xb_ld(&bar[XB_XGEN(b.x)]) == gen, bar);
            __builtin_amdgcn_fence(__ATOMIC_ACQUIRE, "agent");
            asm volatile("s_waitcnt vmcnt(0)" ::: "memory");
        }
    }
    __syncthreads();
}
constexpr int NWAVES = 8;
constexpr int NTOK = 32768, DM = 4096, NIN = 25088, N_A = 12800, N_B = 12288, WA = 2048, CSH = 6656, SEQP = 4096, SEQS = 16384;
constexpr size_t MiB = 1u << 20;
constexpr size_t WS_CTL = 0, CTL_ZERO_BYTES = 1 * MiB;
constexpr size_t WS_ROPE = 2 * MiB;
constexpr size_t WS_LORA = 6 * MiB;
constexpr size_t WS_BONUS = 8 * MiB;
constexpr size_t WS_PART = 16 * MiB;
constexpr size_t WS_WOA = 24 * MiB, WS_WOB = 40 * MiB, WS_WOUT = 56 * MiB;
constexpr size_t WS_WIN = 88 * MiB;
constexpr size_t WS_H = 284 * MiB;
constexpr size_t WS_Q = 540 * MiB, WS_K = 668 * MiB, WS_V = 796 * MiB;
constexpr size_t WS_SLAB = 924 * MiB;
constexpr size_t WS_YB = 1340 * MiB;
constexpr size_t WS_END = 1468 * MiB;
constexpr size_t WS_M = WS_SLAB;
constexpr int CW_QUEUE = 64;
constexpr int CW_BAR = 4096;
constexpr int RING_OFF = 0, RING_BYTES = 143360;
constexpr int MISC_OFF = RING_BYTES;
constexpr int LDS_BYTES = 147456;

struct Frame {
    LAS unsigned char* lds;
    volatile LAS unsigned* MISC;
    gu32* ctl;
    int tid, lane, wave, vcu, G;
};
__device__ __forceinline__ float wave_sum(float v) {
    v += shx<1>(v); v += shx<2>(v); v += shx<4>(v); v += shx<8>(v); v += shx<16>(v); v += shx<32>(v);
    return v;
}
__device__ __forceinline__ float bf2f(bf16 b) { return __builtin_bit_cast(float, (unsigned)b << 16); }

__device__ __forceinline__ void p0_transpose_item(const float* W, int K, int N, bf16* WT, LAS float* scr, int item, int lane, bool permqk) {
    const int nblk = N / 32, kb = item / nblk, nb = item % nblk, k0 = 64 * kb, n0 = 32 * nb;
    int nsrc = n0 + (lane & 31);
    if (permqk && n0 < 4096) { const int dp = nsrc & 63; nsrc = (nsrc & ~63) + ((dp & 1) ? 32 + (dp >> 1) : (dp >> 1)); }
#pragma unroll 8
    for (int i = 0; i < 32; ++i) { const int kk = 2 * i + (lane >> 5); scr[kk * 33 + (lane & 31)] = W[(size_t)(k0 + kk) * N + nsrc]; }
    LDS_WAIT(); asm volatile("" ::: "memory");
    const int c = lane & 7;
#pragma unroll
    for (int j = 0; j < 4; ++j) { const int n = (lane >> 3) + 8 * j; const LAS float* s = scr + (8 * c) * 33 + n;
        v4u o; o.x = pk2(s[0 * 33], s[1 * 33]); o.y = pk2(s[2 * 33], s[3 * 33]); o.z = pk2(s[4 * 33], s[5 * 33]); o.w = pk2(s[6 * 33], s[7 * 33]);
        *(GAS v4u*)(WT + (size_t)(n0 + n) * K + k0 + 8 * c) = o; }
    LDS_WAIT(); asm volatile("" ::: "memory");
}
__device__ __forceinline__ void rms_row_to_bf16(const float* xrow, const float* g, bf16* orow, int lane) {
    const GAS f32x4* xr = (const GAS f32x4*)xrow + lane; const GAS f32x4* gr = (const GAS f32x4*)g + lane;
    f32x4 v[16]; float s = 0.f;
#pragma unroll
    for (int j = 0; j < 16; ++j) { v[j] = xr[64 * j]; s += (v[j].x * v[j].x + v[j].y * v[j].y) + (v[j].z * v[j].z + v[j].w * v[j].w); }
    const float rs = 1.f / sqrtf(wave_sum(s) * (1.f / 4096.f) + 1e-6f);
    GAS unsigned long long* o8 = (GAS unsigned long long*)orow + lane;
#pragma unroll
    for (int j = 0; j < 16; ++j) { const f32x4 gg = gr[64 * j];
        o8[64 * j] = (unsigned long long)pk2(v[j].x * rs * gg.x, v[j].y * rs * gg.y) | ((unsigned long long)pk2(v[j].z * rs * gg.z, v[j].w * rs * gg.w) << 32); }
}
namespace att {
typedef short s16x4 __attribute__((ext_vector_type(4)));
typedef short v4i16_t __attribute__((ext_vector_type(4)));
typedef float f32x16 __attribute__((ext_vector_type(16)));
constexpr int ST_K1 = 0, ST_K2 = 8192, ST_V = 16384, ST_BYTES = 32768;
constexpr int X_OFF = 0, WSF_OFF = 65536;
__device__ __forceinline__ int crow(int r, int hi) { return (r & 3) + 8 * (r >> 2) + 4 * hi; }
__device__ __forceinline__ s16x4 vtr(const LAS unsigned char* p) { return __builtin_bit_cast(s16x4, __builtin_amdgcn_ds_read_tr16_b64_v4i16((LAS v4i16_t*)p)); }
#define ATT_WAITBAR() asm volatile("s_waitcnt vmcnt(0) lgkmcnt(0)\n\ts_barrier" ::: "memory")

__device__ __forceinline__ void attn_unit(LAS unsigned char* lds, const bf16* Q, const bf16* K, const bf16* V, bf16* O, int rb, int Ls, int h, int q0, const LAS float* lamp, const float* subln_g) {
    int tid = threadIdx.x; asm volatile("" : "+v"(tid));
    const int lane = tid & 63, r32 = lane & 31, hi = lane >> 5; const int wid = __builtin_amdgcn_readfirstlane(tid >> 6);
    const int qg = wid >> 1, c = wid & 1;
    LAS float* wsf = (LAS float*)(lds + WSF_OFF) + wid * 64;
    const bf16* src[4]; int dsto[4];
#pragma unroll
    for (int i = 0; i < 4; ++i) { const int p = wid * 4 + i;
        if (p < 16) { src[i] = K + (size_t)(rb + lane) * 2048 + h * 128 + (p >> 3) * 64 + (p & 7) * 8; dsto[i] = (p < 8 ? ST_K1 : ST_K2) + (p & 7) * 1024; }
        else { const int v = p - 16, dh = v >> 2, kg = v & 3; src[i] = V + (size_t)(rb + 16 * kg + (lane >> 2)) * 2048 + h * 128 + 32 * dh + (lane & 3) * 8; dsto[i] = ST_V + v * 1024; } }
#define ATT_DMA(t, stg) do { _Pragma("unroll") for (int i_ = 0; i_ < 4; ++i_) \
        __builtin_amdgcn_global_load_lds((const unsigned*)(src[i_] + (size_t)(t) * 64 * 2048), (LAS unsigned*)(lds + (stg) * ST_BYTES + dsto[i_]), 16, 0, 0); } while (0)
    const int NT = Ls / 64;
    ATT_DMA(0, 0);
    bf16x8 qr[4];
    { const bf16* qp = Q + (size_t)(rb + q0 + qg * 32 + r32) * 2048 + h * 128 + c * 64 + hi * 8;
#pragma unroll
      for (int d0 = 0; d0 < 4; ++d0) qr[d0] = *(const bf16x8*)(qp + d0 * 16); }
    f32x16 o[4];
#pragma unroll
    for (int d = 0; d < 4; ++d) o[d] = (f32x16){};
    float m_run = -1e30f, l_run = 0.f;
    const int koff = (c ? ST_K2 : ST_K1) + hi * 1024 + r32 * 16;
    const int voff = ST_V + (4 * hi + ((lane & 15) >> 2)) * 64 + ((lane >> 4) & 1) * 32 + (lane & 3) * 8;
    for (int t = 0; t < NT; ++t) {
        ATT_WAITBAR();
        if (t + 1 < NT) ATT_DMA(t + 1, (t + 1) & 1);
        const LAS unsigned char* st = lds + (t & 1) * ST_BYTES;
        f32x16 p0 = (f32x16){}, p1 = (f32x16){};
#pragma unroll
        for (int d0 = 0; d0 < 4; ++d0) {
            const bf16x8 a0 = *(const LAS bf16x8*)(st + koff + d0 * 2048), a1 = *(const LAS bf16x8*)(st + koff + d0 * 2048 + 512);
            p0 = __builtin_amdgcn_mfma_f32_32x32x16_bf16(a0, qr[d0], p0, 0, 0, 0);
            p1 = __builtin_amdgcn_mfma_f32_32x32x16_bf16(a1, qr[d0], p1, 0, 0, 0);
        }
        float rm = fmaxf(p0[0], p1[0]);
#pragma unroll
        for (int r = 1; r < 16; ++r) rm = fmaxf(rm, fmaxf(p0[r], p1[r]));
        rm = fmaxf(rm, shx<32>(rm));
        const float mn = fmaxf(m_run, rm);
        const float alpha = __builtin_amdgcn_exp2f(m_run - mn);
        const bool grew = mn > m_run;
        m_run = mn;
        float ls = 0.f;
#pragma unroll
        for (int r = 0; r < 16; ++r) { p0[r] = __builtin_amdgcn_exp2f(p0[r] - mn); p1[r] = __builtin_amdgcn_exp2f(p1[r] - mn); ls += p0[r] + p1[r]; }
        l_run = l_run * alpha + ls;
        if (__any(grew)) {
            if (hi == 0) wsf[r32] = alpha;
            asm volatile("s_waitcnt lgkmcnt(0)" ::: "memory");
#pragma unroll
            for (int r = 0; r < 16; ++r) { const float a = wsf[crow(r, hi)];
#pragma unroll
                for (int d = 0; d < 4; ++d) o[d][r] *= a; }
        }
        u32x4 pw[4];
#pragma unroll
        for (int ks = 0; ks < 4; ++ks) { const int b = 8 * (ks & 1);
            if (ks < 2) pw[ks] = (u32x4){pg8::cvt_pk_bf16(p0[b], p0[b + 1]), pg8::cvt_pk_bf16(p0[b + 2], p0[b + 3]), pg8::cvt_pk_bf16(p0[b + 4], p0[b + 5]), pg8::cvt_pk_bf16(p0[b + 6], p0[b + 7])};
            else        pw[ks] = (u32x4){pg8::cvt_pk_bf16(p1[b], p1[b + 1]), pg8::cvt_pk_bf16(p1[b + 2], p1[b + 3]), pg8::cvt_pk_bf16(p1[b + 4], p1[b + 5]), pg8::cvt_pk_bf16(p1[b + 6], p1[b + 7])}; }
#pragma unroll
        for (int d = 0; d < 4; ++d)
#pragma unroll
            for (int ks = 0; ks < 4; ++ks) {
                const s16x4 lo = vtr(st + voff + (d * 4 + ks) * 1024), hh = vtr(st + voff + (d * 4 + ks) * 1024 + 512);
                const bf16x8 vf = (bf16x8){lo[0], lo[1], lo[2], lo[3], hh[0], hh[1], hh[2], hh[3]};
                o[d] = __builtin_amdgcn_mfma_f32_32x32x16_bf16(__builtin_bit_cast(bf16x8, pw[ks]), vf, o[d], 0, 0, 0);
            }
    }
    l_run += shx<32>(l_run);
    if (hi == 0) wsf[r32] = (c ? *lamp : 1.f) / l_run;
    ATT_WAITBAR();
    LAS float* X = (LAS float*)(lds + X_OFF) + qg * 4096;
    float sc[16];
#pragma unroll
    for (int r = 0; r < 16; ++r) sc[r] = wsf[crow(r, hi)];
    if (c == 1) {
#pragma unroll
        for (int d = 0; d < 4; ++d)
#pragma unroll
            for (int r = 0; r < 16; ++r) X[(d * 16 + r) * 64 + lane] = o[d][r] * sc[r];
    }
    ATT_WAITBAR();
    if (c == 0) {
        float ss[16];
#pragma unroll
        for (int r = 0; r < 16; ++r) { float s = 0.f;
#pragma unroll
            for (int d = 0; d < 4; ++d) { const float y = o[d][r] * sc[r] - X[(d * 16 + r) * 64 + lane]; o[d][r] = y; s += y * y; }
            ss[r] = s; }
#pragma unroll
        for (int r = 0; r < 16; ++r) {
            ss[r] += shx<1>(ss[r]); ss[r] += shx<2>(ss[r]); ss[r] += shx<4>(ss[r]); ss[r] += shx<8>(ss[r]); ss[r] += shx<16>(ss[r]);
            ss[r] = 0.8f / sqrtf(ss[r] * (1.f / 128.f) + 1e-5f); }
        float g[4];
#pragma unroll
        for (int d = 0; d < 4; ++d) g[d] = subln_g[32 * d + r32];
#pragma unroll
        for (int r = 0; r < 16; ++r) { bf16* op = O + (size_t)(rb + q0 + qg * 32 + crow(r, hi)) * 2048 + h * 128 + r32;
#pragma unroll
            for (int d = 0; d < 4; ++d) op[32 * d] = (bf16)f2bf(o[d][r] * ss[r] * g[d]); }
    }
    ATT_WAITBAR();
#undef ATT_DMA
}
}
namespace scan1 {
constexpr int O_W = 0, O_KK = 16384, O_B = 32768, O_KD = 49152, O_R = 65536, O_V = 81920, O_TW = 98304, O_PA = 98304 + 17408, TWS = 136;
struct P { const bf16* SL; const float *mu_prev, *mu_next, *w0, *a0, *k_k, *k_a, *r_k; const bf16* LT; float* YD; float* BON; };
__device__ __forceinline__ void ld8(const bf16* p, bool ok, float (&v)[8]) {
    u32x4 w = ok ? *(const u32x4*)p : (u32x4){0u, 0u, 0u, 0u};
    v[0] = pg8::bflo(w.x); v[1] = pg8::bfhi(w.x); v[2] = pg8::bflo(w.y); v[3] = pg8::bfhi(w.y); v[4] = pg8::bflo(w.z); v[5] = pg8::bfhi(w.z); v[6] = pg8::bflo(w.w); v[7] = pg8::bfhi(w.w);
}
__device__ __forceinline__ void shift8(const P& a, int rb, int Ls, int tok, int col, float (&x)[8]) {
    const bf16* rp = a.SL + (size_t)(rb + tok) * CSH + col; float pc[8], pp[8], pn[8];
    ld8(rp, true, pc); ld8(rp - CSH, tok > 0, pp); ld8(rp + CSH, tok < Ls - 1, pn);
    const f32x4 m0 = *(const f32x4*)(a.mu_prev + col), m1 = *(const f32x4*)(a.mu_prev + col + 4), n0 = *(const f32x4*)(a.mu_next + col), n1 = *(const f32x4*)(a.mu_next + col + 4);
#pragma unroll
    for (int i = 0; i < 8; ++i) { const float mp = i < 4 ? m0[i] : m1[i - 4], mn = i < 4 ? n0[i] : n1[i - 4]; x[i] = pc[i] + mp * (pp[i] - pc[i]) + mn * (pn[i] - pc[i]); }
}
__device__ __forceinline__ void scan_item(Frame& F, const P& a, int seq, int h, int dir) {
    const int rb = seq < 4 ? seq * SEQP : 4 * SEQP, Ls = seq < 4 ? SEQP : SEQS, nch = Ls / 64;
    LAS unsigned char* lds = F.lds;
    LAS float *Wd = (LAS float*)(lds + O_W), *KKs = (LAS float*)(lds + O_KK), *Bs = (LAS float*)(lds + O_B), *KDs = (LAS float*)(lds + O_KD), *Rs = (LAS float*)(lds + O_R), *Vs = (LAS float*)(lds + O_V);
    LAS bf16 *TW = (LAS bf16*)(lds + O_TW), *PA = (LAS bf16*)(lds + O_PA);
    int tid0 = F.tid; asm volatile("" : "+v"(tid0));
    float st[64];
#pragma unroll
    for (int j = 0; j < 64; ++j) st[j] = 0.f;
    for (int ci = 0; ci < nch; ++ci) {
        int tid = tid0; asm volatile("" : "+v"(tid));
        const int lane = tid & 63, wid = __builtin_amdgcn_readfirstlane(tid >> 6);
        { const int s = tid >> 3, c8 = (tid & 7) * 8, tok = dir ? (Ls - 1 - 64 * ci - s) : (64 * ci + s), ch = h * 64 + c8;
          float xr[8], xk[8], xv[8]; shift8(a, rb, Ls, tok, ch, xr); asm volatile("" ::: "memory"); shift8(a, rb, Ls, tok, 2048 + ch, xk); asm volatile("" ::: "memory"); shift8(a, rb, Ls, tok, 4096 + ch, xv); asm volatile("" ::: "memory");
          float kk[8], ss = 0.f;
#pragma unroll
          for (int i = 0; i < 8; ++i) { kk[i] = xk[i] * a.k_k[ch + i]; ss += kk[i] * kk[i]; }
          ss += shx<1>(ss); ss += shx<2>(ss); ss += shx<4>(ss);
          const float inv = 1.f / fmaxf(sqrtf(ss), 1e-12f);
#pragma unroll
          for (int i = 0; i < 8; ++i) { Rs[s * 64 + c8 + i] = xr[i]; Vs[s * 64 + c8 + i] = xv[i]; KDs[s * 64 + c8 + i] = xk[i]; KKs[s * 64 + c8 + i] = kk[i] * inv; } }
        asm volatile("" ::: "memory");
        { const int s = tid >> 3, c16 = (tid & 7) * 16, tok = dir ? (Ls - 1 - 64 * ci - s) : (64 * ci + s);
#pragma unroll
          for (int hf = 0; hf < 2; ++hf) { asm volatile("" ::: "memory"); float xw[8], xa[8]; shift8(a, rb, Ls, tok, 6144 + dir * 128 + c16 + hf * 8, xw); asm volatile("" ::: "memory"); shift8(a, rb, Ls, tok, 6400 + dir * 128 + c16 + hf * 8, xa);
#pragma unroll
              for (int i = 0; i < 8; ++i) { TW[s * TWS + c16 + hf * 8 + i] = (bf16)f2bf(tanhf(xw[i])); PA[s * TWS + c16 + hf * 8 + i] = (bf16)f2bf(xa[i]); } } }
        __syncthreads();
        { const int tm = wid >> 1, fr = lane & 15, fq = lane >> 4;
#pragma unroll
          for (int tt = 0; tt < 2; ++tt) { const int tn = (wid & 1) * 2 + tt; f32x4 aw = (f32x4){0.f, 0.f, 0.f, 0.f}, aa = (f32x4){0.f, 0.f, 0.f, 0.f};
              const bf16* bw = a.LT + ((size_t)(0 * 2 + dir) * 2048 + h * 64 + tn * 16 + fr) * 128 + fq * 8;
              const bf16* ba = a.LT + ((size_t)(1 * 2 + dir) * 2048 + h * 64 + tn * 16 + fr) * 128 + fq * 8;
#pragma unroll
              for (int ks = 0; ks < 4; ++ks) {
                  const bf16x8 fa_w = *(const LAS bf16x8*)(TW + (tm * 16 + fr) * TWS + ks * 32 + fq * 8), fa_a = *(const LAS bf16x8*)(PA + (tm * 16 + fr) * TWS + ks * 32 + fq * 8);
                  const bf16x8 fb_w = *(const bf16x8*)(bw + ks * 32), fb_a = *(const bf16x8*)(ba + ks * 32);
                  aw = __builtin_amdgcn_mfma_f32_16x16x32_bf16(fa_w, fb_w, aw, 0, 0, 0);
                  aa = __builtin_amdgcn_mfma_f32_16x16x32_bf16(fa_a, fb_a, aa, 0, 0, 0); }
              const int n = tn * 16 + fr, chn = h * 64 + n; const float w0v = a.w0[dir * 2048 + chn], a0v = a.a0[dir * 2048 + chn], kav = a.k_a[chn];
#pragma unroll
              for (int i = 0; i < 4; ++i) { const int s = tm * 16 + fq * 4 + i; const float wl = w0v + aw[i], al = a0v + aa[i];
                  const float sp = (-wl > 20.f) ? -wl : log1pf(__expf(-wl));
                  const float dec = __expf(-__expf(-sp - 0.5f)); const float av = 1.f / (1.f + __expf(-al));
                  const float kraw = KDs[s * 64 + n], kkv = KKs[s * 64 + n];
                  Wd[s * 64 + n] = dec; KDs[s * 64 + n] = kraw * (1.f + (av - 1.f) * kav); Bs[s * 64 + n] = kkv * av; } } }
        __syncthreads();
        { const int s = tid >> 3, c8 = (tid & 7) * 8, tok = dir ? (Ls - 1 - 64 * ci - s) : (64 * ci + s); float bs = 0.f;
#pragma unroll
          for (int i = 0; i < 8; ++i) bs += Rs[s * 64 + c8 + i] * KDs[s * 64 + c8 + i] * a.r_k[h * 64 + c8 + i];
          bs += shx<1>(bs); bs += shx<2>(bs); bs += shx<4>(bs);
          if ((tid & 7) == 0) a.BON[((size_t)dir * NTOK + rb + tok) * 32 + h] = bs; }
        if (wid == 0) {
            for (int s = 0; s < 64; ++s) { const int tok = dir ? (Ls - 1 - 64 * ci - s) : (64 * ci + s);
                const LAS float *kkp = KKs + s * 64, *wp = Wd + s * 64, *bp = Bs + s * 64, *kdp = KDs + s * 64, *rp = Rs + s * 64; const float vi = Vs[s * 64 + lane];
                float sa0 = 0.f, sa1 = 0.f;
#pragma unroll
                for (int jb = 0; jb < 64; jb += 8) { const f32x4 k0 = *(const LAS f32x4*)(kkp + jb), k1 = *(const LAS f32x4*)(kkp + jb + 4);
                    sa0 += st[jb] * k0[0]; sa1 += st[jb + 1] * k0[1]; sa0 += st[jb + 2] * k0[2]; sa1 += st[jb + 3] * k0[3];
                    sa0 += st[jb + 4] * k1[0]; sa1 += st[jb + 5] * k1[1]; sa0 += st[jb + 6] * k1[2]; sa1 += st[jb + 7] * k1[3];
                    asm volatile("" ::: "memory"); }
                const float sa = -(sa0 + sa1); float y0 = 0.f, y1 = 0.f;
#pragma unroll
                for (int jb = 0; jb < 64; jb += 4) { const f32x4 w4 = *(const LAS f32x4*)(wp + jb), b4 = *(const LAS f32x4*)(bp + jb), d4 = *(const LAS f32x4*)(kdp + jb), r4 = *(const LAS f32x4*)(rp + jb);
#pragma unroll
                    for (int q = 0; q < 4; ++q) { st[jb + q] = st[jb + q] * w4[q] + sa * b4[q] + vi * d4[q]; }
                    y0 += st[jb] * r4[0]; y1 += st[jb + 1] * r4[1]; y0 += st[jb + 2] * r4[2]; y1 += st[jb + 3] * r4[3];
                    asm volatile("" ::: "memory"); }
                a.YD[((size_t)dir * NTOK + rb + tok) * 2048 + h * 64 + lane] = y0 + y1; }
        }
        __syncthreads();
    }
}
__device__ __forceinline__ void finalize(Frame& F, const P& a, const float* lnx_g, const float* lnx_b, bf16* YB) {
    const int gw = F.vcu * NWAVES + F.wave, NGW = F.G * NWAVES, lane = F.lane;
    for (int row = gw; row < NTOK; row += NGW) { const int seqrow = row < 4 * SEQP ? (row & (SEQP - 1)) : (row - 4 * SEQP), Ls = row < 4 * SEQP ? SEQP : SEQS;
#pragma unroll 2
        for (int it = 0; it < 8; ++it) { const int c = it * 256 + lane * 4, h = c >> 6;
            const f32x4 yf = *(const f32x4*)(a.YD + (size_t)row * 2048 + c), yb = *(const f32x4*)(a.YD + ((size_t)NTOK + row) * 2048 + c);
            f32x4 y = yf + yb; float s = (y.x + y.y) + (y.z + y.w);
            s += shx<1>(s); s += shx<2>(s); s += shx<4>(s); s += shx<8>(s);
            const float mu = s * (1.f / 64.f); y = y - mu; float q = (y.x * y.x + y.y * y.y) + (y.z * y.z + y.w * y.w);
            q += shx<1>(q); q += shx<2>(q); q += shx<4>(q); q += shx<8>(q);
            const float rs = 1.f / sqrtf(q * (1.f / 64.f) + 64e-5f);
            const float bon = a.BON[(size_t)row * 32 + h] + a.BON[((size_t)NTOK + row) * 32 + h];
            const bf16* vp = a.SL + (size_t)row * CSH + 4096 + c; const uint2 pc = *(const uint2*)vp;
            const uint2 pp = seqrow > 0 ? *(const uint2*)(vp - CSH) : make_uint2(0u, 0u), pn = seqrow < Ls - 1 ? *(const uint2*)(vp + CSH) : make_uint2(0u, 0u);
            const f32x4 mp = *(const f32x4*)(a.mu_prev + 4096 + c), mn = *(const f32x4*)(a.mu_next + 4096 + c), g = *(const f32x4*)(lnx_g + c), b = *(const f32x4*)(lnx_b + c);
            const float c0 = pg8::bflo(pc.x), c1 = pg8::bfhi(pc.x), c2 = pg8::bflo(pc.y), c3 = pg8::bfhi(pc.y);
            const float v0 = c0 + mp.x * (pg8::bflo(pp.x) - c0) + mn.x * (pg8::bflo(pn.x) - c0), v1 = c1 + mp.y * (pg8::bfhi(pp.x) - c1) + mn.y * (pg8::bfhi(pn.x) - c1);
            const float v2 = c2 + mp.z * (pg8::bflo(pp.y) - c2) + mn.z * (pg8::bflo(pn.y) - c2), v3 = c3 + mp.w * (pg8::bfhi(pp.y) - c3) + mn.w * (pg8::bfhi(pn.y) - c3);
            uint2 o; o.x = pk2(y.x * rs * g.x + b.x + bon * v0, y.y * rs * g.y + b.y + bon * v1); o.y = pk2(y.z * rs * g.z + b.z + bon * v2, y.w * rs * g.w + b.w + bon * v3);
            *(uint2*)(YB + (size_t)row * 2048 + c) = o; }
    }
}
}
constexpr int NPHASE = 8;
struct Args { const float* in[24]; float* out; unsigned char* ws; int ph_lo, ph_hi; };
__global__ void __launch_bounds__(NWAVES * 64, 2) fwd_kernel(Args args) {
    extern __shared__ __attribute__((aligned(16))) unsigned char lds[];
    Frame F;
    F.lds = (LAS unsigned char*)lds;
    F.MISC = (volatile LAS unsigned*)(F.lds + MISC_OFF);
    F.tid = threadIdx.x; F.lane = F.tid & 63; F.wave = __builtin_amdgcn_readfirstlane(F.tid >> 6);
    F.G = gridDim.x; { const int bx = blockIdx.x; F.vcu = (F.G % 8 == 0) ? (bx % 8) * (F.G / 8) + bx / 8 : bx; }
    unsigned char* ws = args.ws;
    F.ctl = (gu32*)(ws + WS_CTL);
    for (int u = F.tid; u < (LDS_BYTES - MISC_OFF) / 4; u += NWAVES * 64) ((LAS unsigned*)(F.lds + MISC_OFF))[u] = 0u;
    __syncthreads();
    const int lo = args.ph_lo, hi = args.ph_hi;
    XcdBarrier bar; bar.bar = (unsigned*)(F.ctl + CW_BAR); bar.x = 0; bar.st = nullptr;
    if (hi - lo > 1) bar = xcd_barrier_post((unsigned*)(F.ctl + CW_BAR), F.MISC + 8);
#ifdef ONLYPH
#define IN(k) ((k) == ONLYPH && lo <= (k) && (k) < hi)
#else
#define IN(k) (lo <= (k) && (k) < hi)
#endif
#define SEAM(k) do { if (IN(k) && IN((k) + 1)) xcd_barrier(bar); } while (0)
    const float *x_prompt = args.in[0], *x_sample = args.in[1], *norm_g = args.in[2], *w_in = args.in[3], *mu_prev = args.in[4], *mu_next = args.in[5];
    const float *lam_q1 = args.in[6], *lam_k1 = args.in[7], *lam_q2 = args.in[8], *lam_k2 = args.in[9], *subln_g = args.in[10];
    const float *w0 = args.in[11], *w_lora = args.in[12], *a0 = args.in[13], *a_lora = args.in[14], *k_k = args.in[15], *k_a = args.in[16], *r_k = args.in[17];
    const float *lnx_g = args.in[18], *lnx_b = args.in[19], *w_oA = args.in[20], *w_oB = args.in[21], *w_out = args.in[22], *final_g = args.in[23];
    float* ROPE = (float*)(ws + WS_ROPE); bf16* LT = (bf16*)(ws + WS_LORA); float* BON = (float*)(ws + WS_BONUS); float* PART = (float*)(ws + WS_PART);
    bf16 *WOA = (bf16*)(ws + WS_WOA), *WOB = (bf16*)(ws + WS_WOB), *WOUT = (bf16*)(ws + WS_WOUT), *WIN = (bf16*)(ws + WS_WIN), *Hb = (bf16*)(ws + WS_H);
    bf16 *Qb = (bf16*)(ws + WS_Q), *Kb = (bf16*)(ws + WS_K), *Vb = (bf16*)(ws + WS_V), *SL = (bf16*)(ws + WS_SLAB), *YBb = (bf16*)(ws + WS_YB), *Mb = (bf16*)(ws + WS_M);
    bf16* Gb = (bf16*)args.out;
    float* YD = args.out;
    const int gw = F.vcu * NWAVES + F.wave, NGW = F.G * NWAVES;

    if (IN(0)) {
        LAS float* scr = (LAS float*)(F.lds + RING_OFF + F.wave * 16384);
        constexpr int I_IN = (DM / 64) * (NIN / 32), I_OA = (WA / 64) * (DM / 32), I_OUT = (DM / 64) * (DM / 32), I_L = (128 / 64) * (WA / 32);
        constexpr int NITEMS = I_IN + 2 * I_OA + I_OUT + 4 * I_L;
        for (int it = gw; it < NITEMS; it += NGW) {
            int r = it;
            if (r < I_IN) { p0_transpose_item(w_in, DM, NIN, WIN, scr, r, F.lane, true); continue; } r -= I_IN;
            if (r < I_OA) { p0_transpose_item(w_oA, WA, DM, WOA, scr, r, F.lane, false); continue; } r -= I_OA;
            if (r < I_OA) { p0_transpose_item(w_oB, WA, DM, WOB, scr, r, F.lane, false); continue; } r -= I_OA;
            if (r < I_OUT) { p0_transpose_item(w_out, DM, DM, WOUT, scr, r, F.lane, false); continue; } r -= I_OUT;
            const int which = r / I_L; r -= which * I_L;
            p0_transpose_item((which < 2 ? w_lora : a_lora) + (size_t)(which & 1) * 128 * WA, 128, WA, LT + (size_t)which * WA * 128, scr, r, F.lane, false);
        }
        for (int m = gw; m < NTOK; m += NGW) rms_row_to_bf16(m < 4 * SEQP ? x_prompt + (size_t)m * DM : x_sample + (size_t)(m - 4 * SEQP) * DM, norm_g, Hb + (size_t)m * DM, F.lane);
        for (int e = blockIdx.x * (NWAVES * 64) + F.tid; e < SEQS * 32; e += F.G * NWAVES * 64) { const int pos = e >> 5, i = e & 31;
            const float inv = 1.0f / powf(10000.f, (float)(2 * i) / 64.f); const float ang = (float)pos * inv; double sn, cs; sincos((double)ang, &sn, &cs);
            ROPE[2 * e] = (float)cs; ROPE[2 * e + 1] = (float)sn; }
    }
    SEAM(0);
    if (IN(1)) {
        pg8::Gemm g{Hb, WIN, NTOK, N_A, DM}; pg8::StaticOrder S; S.init(NTOK, N_A, F.G, (int)blockIdx.x);
        pg8::EpiInA E{Qb, Kb, Vb, SL, ROPE};
        pg8::gemm_phase<pg8::EpiInA, pg8::StaticOrder, true, true>(F.lds + RING_OFF, g, S, E);
    }
    SEAM(1);
    if (IN(2)) {
        { const float a = wave_sum(lam_q1[F.lane] * lam_k1[F.lane]), b = wave_sum(lam_q2[F.lane] * lam_k2[F.lane]); if (F.tid == 0) F.MISC[1] = __builtin_bit_cast(unsigned, __expf(a) - __expf(b) + 0.2f); }
        __syncthreads();
        const scan1::P sp{SL, mu_prev, mu_next, w0, a0, k_k, k_a, r_k, LT, YD, BON};
        constexpr int N_SS = 64, N_AS = 2048, N_AP = 2048, N_SP = 256, N_ALL = N_SS + N_AS + N_AP + N_SP;
        for (;;) {
            __syncthreads();
            if (F.tid == 0) F.MISC[0] = __hip_atomic_fetch_add(F.ctl + CW_QUEUE, 1u, RLX_AGENT);
            __syncthreads();
            int it = (int)F.MISC[0];
            if (it >= N_ALL) break;
            if (it < N_SS) { scan1::scan_item(F, sp, 4, it >> 1, it & 1); continue; } it -= N_SS;
            if (it < N_AS) { att::attn_unit(F.lds, Qb, Kb, Vb, Qb, 4 * SEQP, SEQS, it >> 7, (it & 127) * 128, (const LAS float*)(F.lds + MISC_OFF + 4), subln_g); continue; } it -= N_AS;
            if (it < N_AP) { const int seq = it >> 9, r = it & 511; att::attn_unit(F.lds, Qb, Kb, Vb, Qb, seq * SEQP, SEQP, r >> 5, (r & 31) * 128, (const LAS float*)(F.lds + MISC_OFF + 4), subln_g); continue; } it -= N_AP;
            scan1::scan_item(F, sp, it >> 6, (it & 63) >> 1, it & 1);
        }
    }
    SEAM(2);
    if (IN(3)) { const scan1::P sp{SL, mu_prev, mu_next, w0, a0, k_k, k_a, r_k, LT, YD, BON}; scan1::finalize(F, sp, lnx_g, lnx_b, YBb); }
    SEAM(3);
    if (IN(4)) {
        { pg8::Gemm g{Hb, WIN + (size_t)N_A * DM, NTOK, 4096, DM}; pg8::StaticOrder S; S.init(NTOK, 4096, F.G, (int)blockIdx.x);
          pg8::EpiZ E{Qb, YBb}; pg8::gemm_phase<pg8::EpiZ, pg8::StaticOrder, true, true>(F.lds + RING_OFF, g, S, E); }
        __syncthreads();
        { pg8::Gemm g{Hb, WIN + (size_t)(N_A + 4096) * DM, NTOK, 8192, DM}; pg8::StaticOrder S; S.init(NTOK, 8192, F.G, (int)blockIdx.x);
          pg8::EpiG E{Gb}; pg8::gemm_phase<pg8::EpiG, pg8::StaticOrder, true, true>(F.lds + RING_OFF, g, S, E); }
    }
    SEAM(4);
    if (IN(5)) {
        pg8::StaticOrder S; S.init(NTOK, DM, F.G, (int)blockIdx.x);
        { pg8::Gemm g{Qb, WOA, NTOK, DM, WA}; pg8::EpiM<false> E{Mb, Gb}; pg8::gemm_phase<pg8::EpiM<false>, pg8::StaticOrder, true, true>(F.lds + RING_OFF, g, S, E); }
        __syncthreads();
        { pg8::Gemm g{YBb, WOB, NTOK, DM, WA}; pg8::EpiM<true> E{Mb, Gb}; pg8::gemm_phase<pg8::EpiM<true>, pg8::StaticOrder, true, true>(F.lds + RING_OFF, g, S, E); }
    }
    SEAM(5);
    if (IN(6)) {
        pg8::Gemm g{Mb, WOUT, NTOK, DM, DM}; pg8::StaticOrder S; S.init(NTOK, DM, F.G, (int)blockIdx.x);
        pg8::EpiOut E{x_prompt, x_sample, args.out, PART};
        pg8::gemm_phase<pg8::EpiOut, pg8::StaticOrder, true, true>(F.lds + RING_OFF, g, S, E);
    }
    SEAM(6);
    if (IN(7)) {
        const bool poison = (hi - lo > 1) && (__hip_atomic_load((gu32*)((unsigned*)(F.ctl + CW_BAR) + XB_TMO), RLX_AGENT) != 0u);
        for (int row = gw; row < NTOK; row += NGW) {
            const float ss = wave_sum(PART[(size_t)row * 64 + F.lane]); float rs = 1.f / sqrtf(ss * (1.f / 4096.f) + 1e-6f);
            if (poison) rs = __builtin_nanf("");
            GAS f32x4* o = (GAS f32x4*)(args.out + (size_t)row * DM) + F.lane; const GAS f32x4* gg = (const GAS f32x4*)final_g + F.lane;
#pragma unroll
            for (int j = 0; j < 16; ++j) { const f32x4 v = o[64 * j]; o[64 * j] = v * rs * gg[64 * j]; }
        }
    }
#undef IN
#undef SEAM
}

extern "C" void kernel_launch(void* const* d_in, const int* in_sizes, int n_in, void* d_out, int out_size, void* d_ws, size_t ws_size, hipStream_t stream) {
    static int grid = 0;
    if (grid == 0) {
        if (n_in != 24 || in_sizes[0] != 4 * SEQP * DM || out_size != NTOK * DM || ws_size < WS_END) { fprintf(stderr, "kernel_launch: unexpected shapes / workspace (n_in %d, ws %zu); nothing launched\n", n_in, ws_size); grid = -1; return; }
        int dev = 0, cus = 0, per_cu = 0;
        if (hipGetDevice(&dev) != hipSuccess || hipDeviceGetAttribute(&cus, hipDeviceAttributeMultiprocessorCount, dev) != hipSuccess) { grid = -1; return; }
        if (hipFuncSetAttribute((const void*)fwd_kernel, hipFuncAttributeMaxDynamicSharedMemorySize, LDS_BYTES) != hipSuccess) { fprintf(stderr, "kernel_launch: hipFuncSetAttribute failed\n"); grid = -1; return; }
        if (hipOccupancyMaxActiveBlocksPerMultiprocessor(&per_cu, (const void*)fwd_kernel, NWAVES * 64, LDS_BYTES) != hipSuccess || per_cu < 1) { fprintf(stderr, "kernel_launch: occupancy query says %d\n", per_cu); }
        (void)hipGetLastError();
        grid = cus;
    }
    if (grid < 0) return;
    if (hipMemsetAsync((char*)d_ws + WS_CTL, 0, CTL_ZERO_BYTES, stream) != hipSuccess) return;
    Args a{};
    for (int i = 0; i < 24; ++i) a.in[i] = (const float*)d_in[i];
    a.out = (float*)d_out; a.ws = (unsigned char*)d_ws;
#if MK_SINGLE
    a.ph_lo = 0; a.ph_hi = NPHASE;
    hipLaunchKernelGGL(fwd_kernel, dim3(grid), dim3(NWAVES * 64), LDS_BYTES, stream, a);
#else
    for (int p = 0; p < NPHASE; ++p) { a.ph_lo = p; a.ph_hi = p + 1; hipLaunchKernelGGL(fwd_kernel, dim3(grid), dim3(NWAVES * 64), LDS_BYTES, stream, a); }
#endif
}
```

```cpp
#include <hip/hip_runtime.h>
#include <cstdio>
#include <cstdint>

#ifndef MK_SINGLE
#define MK_SINGLE 1
#endif

template <int K> __device__ __forceinline__ float shx(float v) {
    if constexpr (K == 32) { const unsigned u = __builtin_bit_cast(unsigned, v); auto rr = __builtin_amdgcn_permlane32_swap(u, u, false, false);
        return __builtin_bit_cast(float, (threadIdx.x & 32) ? rr[0] : rr[1]); }
    else return __builtin_bit_cast(float, __builtin_amdgcn_ds_swizzle(__builtin_bit_cast(int, v), (K << 10) | 0x1f));
}
namespace pg8 {
#define PG8_LAS __attribute__((address_space(3)))
typedef unsigned short bf16_t;
typedef short bf16x8 __attribute__((ext_vector_type(8)));
typedef float f32x4 __attribute__((ext_vector_type(4)));
typedef unsigned u32x4 __attribute__((ext_vector_type(4)));
constexpr int BM = 256, BK = 64, HALF = 128, HTB = HALF * BK * 2  , STAGE_BYTES = 8 * HTB, NXCD = 8, WGM = 8;

__host__ __device__ __forceinline__ int lds_byte(int r, int c) { const int st = (r >> 4) * 2 + (c >> 5), rr = r & 15, cc = c & 31, ob = rr * 64 + cc * 2; return st * 1024 + (ob ^ (((ob >> 9) & 1) << 5)); }
__host__ __device__ __forceinline__ void stage_rc(int b, int& R, int& C) { const int st = b / 1024, sb = b % 1024, swz = sb ^ (((sb >> 9) & 1) << 5); R = (st >> 1) * 16 + swz / 64; C = (st & 1) * 32 + (swz % 64) / 2; }
__host__ __device__ __forceinline__ int perm32(int rho) { const int n = rho >> 4, i = rho & 15; return 8 * (i >> 2) + 4 * n + (i & 3); }

struct Unit { int pm, pn; };
struct Gemm { const bf16_t* A; const bf16_t* Bt; int M, N, K; };

struct StaticOrder {
    int nM, nN, nwg, G, c;
    __host__ __device__ void init(int M, int N, int G_, int c_) { nM = M / BM; nN = N / BM; nwg = nM * nN; G = G_; c = c_; }
    __host__ __device__ bool next(int i, Unit& u) const {
        const long L = (long)i * G + c; if (L >= nwg) return false;
        int wgid = (int)L; { const int q = nwg / NXCD, r = nwg % NXCD, xcd = wgid % NXCD, off = wgid / NXCD; wgid = (xcd < r ? xcd * (q + 1) : r * (q + 1) + (xcd - r) * q) + off; }
        const int nig = WGM * nN, gid = wgid / nig, fm = gid * WGM, gsz = (nM - fm) < WGM ? (nM - fm) : WGM;
        u.pm = fm + ((wgid % nig) % gsz); u.pn = (wgid % nig) / gsz; return true;
    }
    __device__ __forceinline__ void a_ready(const Unit&) const {}
    __device__ __forceinline__ void done(const Unit&) const {}
};
typedef float f32x2_t __attribute__((ext_vector_type(2))); typedef __bf16 bf16x2_t __attribute__((ext_vector_type(2)));
__device__ __forceinline__ unsigned cvt_pk_bf16(float lo, float hi) { f32x2_t v = {lo, hi}; bf16x2_t b = __builtin_convertvector(v, bf16x2_t); return __builtin_bit_cast(unsigned, b); }
__device__ __forceinline__ float bflo(unsigned w) { return __builtin_bit_cast(float, w << 16); }
__device__ __forceinline__ float bfhi(unsigned w) { return __builtin_bit_cast(float, w & 0xffff0000u); }
__device__ __forceinline__ float fast_sigmoid(float x) { return __builtin_amdgcn_rcpf(1.f + __builtin_amdgcn_exp2f(-1.4426950408889634f * x)); }
constexpr float C2 = 0.125f * 1.4426950408889634f;
__host__ __device__ __forceinline__ size_t kt_index(int row, int col) { const int h = col >> 7, m = (col >> 6) & 1, c = (col >> 3) & 7;
    return ((((size_t)(row >> 6) * 16 + h) * 2 + m) * 8 + c) * 512 + (size_t)(row & 63) * 8 + (col & 7); }
__host__ __device__ __forceinline__ size_t vt_index(int row, int col) { const int h = col >> 7, cv = col & 127;
    return ((((size_t)(row >> 6) * 16 + h) * 16 + (cv >> 5) * 4 + ((row >> 4) & 3)) * 16 + (row & 15)) * 32 + (cv & 31); }
struct EpiInA {
    static constexpr bool PERM = true, AFTER_DRAIN = false;
    bf16_t *Q, *K, *V, *SL; const float* rope;
    __device__ __forceinline__ void operator()(const f32x4 (&acc)[2][2][4][2], const Unit& u, int wr, int wc, int fr, int fq) const {
        const int pn = u.pn, row0 = u.pm * BM + wr * 64 + fr;
        if (pn < 16) {
            const float sc = pn < 8 ? C2 : 1.f; const int colt = (pn & 7) * BM + wc * 32 + 8 * fq;
#pragma unroll
            for (int ai = 0; ai < 2; ++ai) {
                f32x4 tt[4][2][2];
#pragma unroll
                for (int m = 0; m < 4; ++m) { const int row = row0 + ai * HALF + m * 16; const int pos = row < 16384 ? (row & 4095) : (row - 16384);
#pragma unroll
                    for (int bj = 0; bj < 2; ++bj) { const int i0 = ((colt + bj * HALF) & 63) >> 1; const f32x4* tp = (const f32x4*)(rope + ((size_t)pos * 32 + i0) * 2); tt[m][bj][0] = tp[0]; tt[m][bj][1] = tp[1]; } }
                __builtin_amdgcn_sched_barrier(0);
#pragma unroll
                for (int m = 0; m < 4; ++m) { const int row = row0 + ai * HALF + m * 16;
#pragma unroll
                    for (int bj = 0; bj < 2; ++bj) { bf16_t* dst = pn < 8 ? Q + (size_t)row * 2048 + colt + bj * HALF : K + kt_index(row, colt + bj * HALF);
                        const f32x4 t0 = tt[m][bj][0], t1 = tt[m][bj][1];
                        const f32x4 v0 = acc[ai][bj][m][0], v1 = acc[ai][bj][m][1]; u32x4 w;
                        w.x = cvt_pk_bf16((v0[0] * t0[0] - v0[1] * t0[1]) * sc, (v0[1] * t0[0] + v0[0] * t0[1]) * sc);
                        w.y = cvt_pk_bf16((v0[2] * t0[2] - v0[3] * t0[3]) * sc, (v0[3] * t0[2] + v0[2] * t0[3]) * sc);
                        w.z = cvt_pk_bf16((v1[0] * t1[0] - v1[1] * t1[1]) * sc, (v1[1] * t1[0] + v1[0] * t1[1]) * sc);
                        w.w = cvt_pk_bf16((v1[2] * t1[2] - v1[3] * t1[3]) * sc, (v1[3] * t1[2] + v1[2] * t1[3]) * sc);
                        *(u32x4*)dst = w; __builtin_amdgcn_sched_barrier(0); } } }
        } else {
            bf16_t* base; int ldc, colt;
            if (pn < 24) { base = V; ldc = 2048; colt = (pn - 16) * BM; } else { base = SL; ldc = 6656; colt = (pn - 24) * BM; }
            colt += wc * 32 + 8 * fq;
#pragma unroll
            for (int ai = 0; ai < 2; ++ai)
#pragma unroll
                for (int m = 0; m < 4; ++m) { const int row = row0 + ai * HALF + m * 16;
#pragma unroll
                    for (int bj = 0; bj < 2; ++bj) { const f32x4 v0 = acc[ai][bj][m][0], v1 = acc[ai][bj][m][1]; u32x4 w;
                        w.x = cvt_pk_bf16(v0[0], v0[1]); w.y = cvt_pk_bf16(v0[2], v0[3]); w.z = cvt_pk_bf16(v1[0], v1[1]); w.w = cvt_pk_bf16(v1[2], v1[3]);
                        bf16_t* dst = pn < 24 ? base + vt_index(row, colt + bj * HALF) : base + (size_t)row * ldc + colt + bj * HALF;
                        *(u32x4*)dst = w; __builtin_amdgcn_sched_barrier(0); } }
        }
    }
};
struct EpiZ {
    static constexpr bool PERM = true, AFTER_DRAIN = false;
    bf16_t *YA, *YB;
    __device__ __forceinline__ void operator()(const f32x4 (&acc)[2][2][4][2], const Unit& u, int wr, int wc, int fr, int fq) const {
        const int pn = u.pn, row0 = u.pm * BM + wr * 64 + fr;
        bf16_t* base = pn < 8 ? YA : YB; const int colt = (pn & 7) * BM + wc * 32 + 8 * fq;
#pragma unroll
        for (int ai = 0; ai < 2; ++ai)
#pragma unroll
            for (int m = 0; m < 4; ++m) { bf16_t* rowp = base + (size_t)(row0 + ai * HALF + m * 16) * 2048 + colt;
#pragma unroll
                for (int bj = 0; bj < 2; ++bj) { const f32x4 v0 = acc[ai][bj][m][0], v1 = acc[ai][bj][m][1]; const u32x4 y = *(const u32x4*)(rowp + bj * HALF); u32x4 w;
                    w.x = cvt_pk_bf16(bflo(y.x) * v0[0] * fast_sigmoid(v0[0]), bfhi(y.x) * v0[1] * fast_sigmoid(v0[1]));
                    w.y = cvt_pk_bf16(bflo(y.y) * v0[2] * fast_sigmoid(v0[2]), bfhi(y.y) * v0[3] * fast_sigmoid(v0[3]));
                    w.z = cvt_pk_bf16(bflo(y.z) * v1[0] * fast_sigmoid(v1[0]), bfhi(y.z) * v1[1] * fast_sigmoid(v1[1]));
                    w.w = cvt_pk_bf16(bflo(y.w) * v1[2] * fast_sigmoid(v1[2]), bfhi(y.w) * v1[3] * fast_sigmoid(v1[3]));
                    *(u32x4*)(rowp + bj * HALF) = w; __builtin_amdgcn_sched_barrier(0); } }
    }
};
struct EpiG {
    static constexpr bool PERM = true, AFTER_DRAIN = false;
    bf16_t* G;
    __device__ __forceinline__ void operator()(const f32x4 (&acc)[2][2][4][2], const Unit& u, int wr, int wc, int fr, int fq) const {
        const int row0 = u.pm * BM + wr * 64 + fr, colt = u.pn * BM + wc * 32 + 8 * fq;
#pragma unroll
        for (int ai = 0; ai < 2; ++ai)
#pragma unroll
            for (int m = 0; m < 4; ++m) { bf16_t* rowp = G + (size_t)(row0 + ai * HALF + m * 16) * 8192 + colt;
#pragma unroll
                for (int bj = 0; bj < 2; ++bj) { const f32x4 v0 = acc[ai][bj][m][0], v1 = acc[ai][bj][m][1]; u32x4 w;
                    w.x = cvt_pk_bf16(fast_sigmoid(v0[0]), fast_sigmoid(v0[1])); w.y = cvt_pk_bf16(fast_sigmoid(v0[2]), fast_sigmoid(v0[3]));
                    w.z = cvt_pk_bf16(fast_sigmoid(v1[0]), fast_sigmoid(v1[1])); w.w = cvt_pk_bf16(fast_sigmoid(v1[2]), fast_sigmoid(v1[3]));
                    *(u32x4*)(rowp + bj * HALF) = w; __builtin_amdgcn_sched_barrier(0); } }
    }
};
template <bool SECOND> struct EpiM {
    static constexpr bool PERM = true, AFTER_DRAIN = false;
    bf16_t* Mb; const bf16_t* G;
    __device__ __forceinline__ void operator()(const f32x4 (&acc)[2][2][4][2], const Unit& u, int wr, int wc, int fr, int fq) const {
        const int row0 = u.pm * BM + wr * 64 + fr, colt = u.pn * BM + wc * 32 + 8 * fq;
#pragma unroll
        for (int ai = 0; ai < 2; ++ai)
#pragma unroll
            for (int m = 0; m < 4; ++m) { const size_t row = (size_t)(row0 + ai * HALF + m * 16); bf16_t* rowp = Mb + row * 4096 + colt; const bf16_t* gp = G + row * 8192 + (SECOND ? 4096 : 0) + colt;
#pragma unroll
                for (int bj = 0; bj < 2; ++bj) { const f32x4 v0 = acc[ai][bj][m][0], v1 = acc[ai][bj][m][1]; const u32x4 g = *(const u32x4*)(gp + bj * HALF);
                    float o[8] = {bflo(g.x) * v0[0], bfhi(g.x) * v0[1], bflo(g.y) * v0[2], bfhi(g.y) * v0[3], bflo(g.z) * v1[0], bfhi(g.z) * v1[1], bflo(g.w) * v1[2], bfhi(g.w) * v1[3]};
                    if (SECOND) { const u32x4 p = *(const u32x4*)(rowp + bj * HALF);
                        o[0] += bflo(p.x); o[1] += bfhi(p.x); o[2] += bflo(p.y); o[3] += bfhi(p.y); o[4] += bflo(p.z); o[5] += bfhi(p.z); o[6] += bflo(p.w); o[7] += bfhi(p.w); }
                    u32x4 w; w.x = cvt_pk_bf16(o[0], o[1]); w.y = cvt_pk_bf16(o[2], o[3]); w.z = cvt_pk_bf16(o[4], o[5]); w.w = cvt_pk_bf16(o[6], o[7]);
                    *(u32x4*)(rowp + bj * HALF) = w; __builtin_amdgcn_sched_barrier(0); } }
    }
};
struct EpiOut {
    static constexpr bool PERM = true, AFTER_DRAIN = false;
    const float *xp, *xs; bf16_t* pre; float* part;
    __device__ __forceinline__ void operator()(const f32x4 (&acc)[2][2][4][2], const Unit& u, int wr, int wc, int fr, int fq) const {
        const int row0 = u.pm * BM + wr * 64 + fr, colt = u.pn * BM + wc * 32 + 8 * fq;
#pragma unroll
        for (int ai = 0; ai < 2; ++ai)
#pragma unroll
            for (int m = 0; m < 4; ++m) { const int row = row0 + ai * HALF + m * 16;
                const float* xr = (row < 16384 ? xp + (size_t)row * 4096 : xs + (size_t)(row - 16384) * 4096) + colt; bf16_t* orow = pre + (size_t)row * 4096 + colt; float ss = 0.f;
#pragma unroll
                for (int bj = 0; bj < 2; ++bj) { const f32x4 a0 = *(const f32x4*)(xr + bj * HALF), a1 = *(const f32x4*)(xr + bj * HALF + 4);
                    const f32x4 o0 = a0 + acc[ai][bj][m][0], o1 = a1 + acc[ai][bj][m][1];
                    ss += (o0[0] * o0[0] + o0[1] * o0[1]) + (o0[2] * o0[2] + o0[3] * o0[3]) + (o1[0] * o1[0] + o1[1] * o1[1]) + (o1[2] * o1[2] + o1[3] * o1[3]);
                    u32x4 w; w.x = cvt_pk_bf16(o0[0], o0[1]); w.y = cvt_pk_bf16(o0[2], o0[3]); w.z = cvt_pk_bf16(o1[0], o1[1]); w.w = cvt_pk_bf16(o1[2], o1[3]); *(u32x4*)(orow + bj * HALF) = w; }
                ss += shx<16>(ss); ss += shx<32>(ss);
                if (fq == 0) part[(size_t)row * 64 + u.pn * 4 + wc] = ss; }
    }
};
template <class Epi, class Sched, bool ALIGN_EPI = false, bool SP2 = false>
__device__ __forceinline__ void gemm_phase(PG8_LAS unsigned char* lds, const Gemm g, const Sched& S, const Epi& E) {
    const int tid = threadIdx.x, wid = __builtin_amdgcn_readfirstlane(tid >> 6), lane = tid & 63, wr = wid >> 2, wc = wid & 3, fr = lane & 15, fq = lane >> 4;
    const int K = g.K, nt = K / BK;
    unsigned voffA[2], voffB[2];
#pragma unroll
    for (int i = 0; i < 2; ++i) { int R, C; stage_rc(tid * 16 + i * 8192, R, C); const int Rb = Epi::PERM ? ((R & ~31) + perm32(R & 31)) : R;
        voffA[i] = (unsigned)(R * K + C) * 2u; voffB[i] = (unsigned)(Rb * K + C) * 2u; }
    const size_t kstep = (size_t)(BK * 2);
    const size_t hstep = (size_t)HALF * K * 2;
    const size_t tstep = 2 * hstep;
    const unsigned ldsw = (unsigned)wid * 1024u;
    const int aoff = lds_byte(wr * 64 + fr, fq * 8), boff = lds_byte(wc * 32 + fr, fq * 8);
#define PG8_SA(b, h) (((b) * 2 + (h)) * HTB)
#define PG8_SB(b, h) ((4 + (b) * 2 + (h)) * HTB)
#define PG8_STAGE(bufoff, gbase, voff) do { _Pragma("unroll") for (int _i = 0; _i < 2; ++_i) \
        __builtin_amdgcn_global_load_lds((const unsigned*)((const char*)(gbase) + (voff)[_i]), (PG8_LAS unsigned*)(lds + (bufoff) + ldsw + _i * 8192), 16, 0, 0); } while (0)
#define PG8_LDA(dst, b, h) do { _Pragma("unroll") for (int m = 0; m < 4; ++m) _Pragma("unroll") for (int k = 0; k < 2; ++k) dst[m][k] = *(const PG8_LAS bf16x8*)(lds + PG8_SA(b, h) + aoff + m * 2048 + k * 1024); } while (0)
#define PG8_LDB(dst, b, h) do { _Pragma("unroll") for (int n = 0; n < 2; ++n) _Pragma("unroll") for (int k = 0; k < 2; ++k) dst[n][k] = *(const PG8_LAS bf16x8*)(lds + PG8_SB(b, h) + boff + n * 2048 + k * 1024); } while (0)
#define PG8_MMA(ai, bj, At, Bt) do { __builtin_amdgcn_s_setprio(1); _Pragma("unroll") for (int m = 0; m < 4; ++m) _Pragma("unroll") for (int n = 0; n < 2; ++n) _Pragma("unroll") for (int k = 0; k < 2; ++k) \
        acc[ai][bj][m][n] = __builtin_amdgcn_mfma_f32_16x16x32_bf16(Bt[n][k], At[m][k], acc[ai][bj][m][n], 0, 0, 0); __builtin_amdgcn_s_setprio(0); } while (0)
#define PG8_WAIT_V(n) asm volatile("s_waitcnt vmcnt(" #n ")" ::: "memory")
#define PG8_WAIT_L(n) asm volatile("s_waitcnt lgkmcnt(" #n ")" ::: "memory")
#define PG8_BAR __builtin_amdgcn_s_barrier()
#define PG8_SCHED __builtin_amdgcn_sched_barrier(0)
    Unit cur, nxt; int ui = 0;
    if (!S.next(0, cur)) return;
    f32x4 acc[2][2][4][2];
#pragma unroll
    for (int a = 0; a < 2; ++a)
#pragma unroll
        for (int b = 0; b < 2; ++b)
#pragma unroll
            for (int m = 0; m < 4; ++m)
#pragma unroll
                for (int n = 0; n < 2; ++n) acc[a][b][m][n] = (f32x4){0.f, 0.f, 0.f, 0.f};
    bf16x8 At[4][2], B0[2][2], B1[2][2];
    const char* cA = (const char*)g.A + (size_t)cur.pm * tstep; const char* cB = (const char*)g.Bt + (size_t)cur.pn * tstep;
    S.a_ready(cur);
    if constexpr (SP2) {
        PG8_STAGE(PG8_SB(0, 0), cB, voffB); PG8_STAGE(PG8_SB(0, 1), cB + hstep, voffB); PG8_STAGE(PG8_SA(0, 0), cA, voffA); PG8_STAGE(PG8_SA(0, 1), cA + hstep, voffA);
        if (wr == 1) PG8_BAR;
        PG8_WAIT_V(2); PG8_BAR;
        PG8_STAGE(PG8_SB(1, 0), cB + kstep, voffB); PG8_STAGE(PG8_SA(1, 0), cA + kstep, voffA); PG8_STAGE(PG8_SB(1, 1), cB + hstep + kstep, voffB);
        PG8_WAIT_V(6); PG8_BAR;
    } else {
        PG8_STAGE(PG8_SB(0, 0), cB, voffB); PG8_STAGE(PG8_SA(0, 0), cA, voffA); PG8_STAGE(PG8_SB(0, 1), cB + hstep, voffB); PG8_STAGE(PG8_SA(0, 1), cA + hstep, voffA);
        if (wr == 1) PG8_BAR;
        PG8_WAIT_V(4); PG8_BAR;
        PG8_STAGE(PG8_SB(1, 0), cB + kstep, voffB); PG8_STAGE(PG8_SA(1, 0), cA + kstep, voffA); PG8_STAGE(PG8_SB(1, 1), cB + hstep + kstep, voffB);
        PG8_WAIT_V(6); PG8_BAR;
    }
    for (;;) {
        const bool has_next = S.next(ui + 1, nxt);
        const char* nA = has_next ? (const char*)g.A + (size_t)nxt.pm * tstep : cA; const char* nB = has_next ? (const char*)g.Bt + (size_t)nxt.pn * tstep : cB;
        for (int t = 0; t < nt; t += 2) {
            const bool last = (t == nt - 2);
            const char* a1 = cA + (size_t)(t + 1) * kstep;
            const char* a2 = last ? nA : cA + (size_t)(t + 2) * kstep; const char* b2 = last ? nB : cB + (size_t)(t + 2) * kstep;
            const char* a3 = a2 + kstep; const char* b3 = b2 + kstep;
            if (last && has_next) S.a_ready(nxt);
            if constexpr (SP2) {
            PG8_LDB(B0, 0, 0); PG8_LDB(B1, 0, 1); PG8_SCHED; PG8_LDA(At, 0, 0); PG8_STAGE(PG8_SA(1, 1), a1 + hstep, voffA);
            PG8_WAIT_V(8); PG8_WAIT_L(0); PG8_BAR; PG8_MMA(0, 0, At, B0); PG8_MMA(0, 1, At, B1); PG8_BAR; PG8_SCHED;
            PG8_LDA(At, 0, 1); PG8_STAGE(PG8_SB(0, 0), b2, voffB); PG8_STAGE(PG8_SB(0, 1), b2 + hstep, voffB); PG8_STAGE(PG8_SA(0, 0), a2, voffA);
            PG8_WAIT_V(8); PG8_WAIT_L(0); PG8_BAR; PG8_MMA(1, 0, At, B0); PG8_MMA(1, 1, At, B1); PG8_BAR; PG8_SCHED;
            PG8_LDB(B0, 1, 0); PG8_LDB(B1, 1, 1); PG8_SCHED; PG8_LDA(At, 1, 0); PG8_STAGE(PG8_SA(0, 1), a2 + hstep, voffA);
            PG8_WAIT_V(8); PG8_WAIT_L(0); PG8_BAR; PG8_MMA(0, 0, At, B0); PG8_MMA(0, 1, At, B1); PG8_BAR; PG8_SCHED;
            PG8_LDA(At, 1, 1); PG8_STAGE(PG8_SB(1, 0), b3, voffB); PG8_STAGE(PG8_SB(1, 1), b3 + hstep, voffB); PG8_STAGE(PG8_SA(1, 0), a3, voffA);
            PG8_WAIT_V(8); PG8_WAIT_L(0); PG8_BAR; PG8_MMA(1, 0, At, B0); PG8_MMA(1, 1, At, B1); PG8_BAR; PG8_SCHED;
            } else {
            PG8_LDB(B0, 0, 0); PG8_SCHED; PG8_LDA(At, 0, 0); PG8_STAGE(PG8_SA(1, 1), a1 + hstep, voffA);
            PG8_WAIT_L(8); PG8_BAR; PG8_WAIT_L(0); PG8_MMA(0, 0, At, B0); PG8_BAR; PG8_SCHED;
            PG8_LDB(B1, 0, 1); PG8_STAGE(PG8_SB(0, 0), b2, voffB);
            PG8_BAR; PG8_WAIT_L(0); PG8_MMA(0, 1, At, B1); PG8_BAR;
            PG8_LDA(At, 0, 1); PG8_STAGE(PG8_SA(0, 0), a2, voffA);
            PG8_BAR; PG8_WAIT_L(0); PG8_MMA(1, 0, At, B0); PG8_BAR; PG8_SCHED;
            PG8_STAGE(PG8_SB(0, 1), b2 + hstep, voffB);
            PG8_WAIT_V(6); PG8_BAR; PG8_MMA(1, 1, At, B1); PG8_BAR;
            PG8_LDB(B0, 1, 0); PG8_SCHED; PG8_LDA(At, 1, 0); PG8_STAGE(PG8_SA(0, 1), a2 + hstep, voffA);
            PG8_WAIT_L(8); PG8_BAR; PG8_WAIT_L(0); PG8_MMA(0, 0, At, B0); PG8_BAR; PG8_SCHED;
            PG8_LDB(B1, 1, 1); PG8_STAGE(PG8_SB(1, 0), b3, voffB);
            PG8_BAR; PG8_WAIT_L(0); PG8_MMA(0, 1, At, B1); PG8_BAR;
            PG8_LDA(At, 1, 1); PG8_STAGE(PG8_SA(1, 0), a3, voffA);
            PG8_BAR; PG8_WAIT_L(0); PG8_MMA(1, 0, At, B0); PG8_BAR; PG8_SCHED;
            PG8_STAGE(PG8_SB(1, 1), b3 + hstep, voffB);
            PG8_WAIT_V(6); PG8_BAR; PG8_MMA(1, 1, At, B1); PG8_BAR;
            }
        }
        if constexpr (ALIGN_EPI) { if (wr == 0) PG8_BAR; }
        if constexpr (!Epi::AFTER_DRAIN) { E(acc, cur, wr, wc, fr, fq); S.done(cur); }
        if (!has_next) break;
#pragma unroll
        for (int a = 0; a < 2; ++a)
#pragma unroll
            for (int b = 0; b < 2; ++b)
#pragma unroll
                for (int m = 0; m < 4; ++m)
#pragma unroll
                    for (int n = 0; n < 2; ++n) acc[a][b][m][n] = (f32x4){0.f, 0.f, 0.f, 0.f};
        cur = nxt; cA = nA; cB = nB; ++ui;
        if constexpr (ALIGN_EPI) { if (wr == 1) PG8_BAR; }
    }
    PG8_WAIT_V(0);
    if constexpr (!ALIGN_EPI) { if (wr == 0) PG8_BAR; }
    PG8_BAR;
    if constexpr (Epi::AFTER_DRAIN) { E.fused(acc, cur, wr, wc, fr, fq, lds, wid, lane); S.done(cur); }
#undef PG8_SA
#undef PG8_SB
#undef PG8_STAGE
#undef PG8_LDA
#undef PG8_LDB
#undef PG8_MMA
#undef PG8_WAIT_V
#undef PG8_WAIT_L
#undef PG8_BAR
#undef PG8_SCHED
}
}
typedef unsigned u32x4 __attribute__((ext_vector_type(4)));
#define GAS __attribute__((address_space(1)))
#define LAS __attribute__((address_space(3)))
typedef unsigned short bf16;
typedef unsigned v4u __attribute__((ext_vector_type(4)));
typedef float f32x4 __attribute__((ext_vector_type(4)));
typedef short bf16x8 __attribute__((ext_vector_type(8)));
typedef GAS unsigned gu32;
typedef GAS unsigned long long gu64;
#define RLX_AGENT __ATOMIC_RELAXED, __HIP_MEMORY_SCOPE_AGENT
#define LDS_WAIT() asm volatile("s_waitcnt lgkmcnt(0)" ::: "memory")
#define VM_WAIT() asm volatile("s_waitcnt vmcnt(0)" ::: "memory")
__device__ __forceinline__ unsigned long long rt() { return __builtin_amdgcn_s_memrealtime(); }
__device__ __forceinline__ unsigned f2bf(float f) { unsigned u = __builtin_bit_cast(unsigned, f); return (u + 0x7fffu + ((u >> 16) & 1u)) >> 16; }
__device__ __forceinline__ unsigned pk2(float lo, float hi) { return f2bf(lo) | (f2bf(hi) << 16); }
#define XB_TMO      128
#define XB_XCNT(j)  (256  + 64 * (j))
#define XB_XSUB(j)  (1280 + 64 * (j))
#define XB_XGEN(j)  (2304 + 64 * (j))
#define XB_TOP      3328
#define XB_TOPGEN   3392
#define XCD_BAR_WORDS 3456
#define XB_SPIN_CAP (1u << 21)

__device__ __forceinline__ unsigned xb_ld(unsigned* p)              { return __hip_atomic_load(p, __ATOMIC_RELAXED, __HIP_MEMORY_SCOPE_AGENT); }
__device__ __forceinline__ unsigned xb_add(unsigned* p, unsigned v) { return __hip_atomic_fetch_add(p, v, __ATOMIC_RELAXED, __HIP_MEMORY_SCOPE_AGENT); }
__device__ __forceinline__ unsigned xb_xcc_id() { return (unsigned)__builtin_amdgcn_s_getreg((3 << 11) | 20) & 0xFu; }
#define XB_SPIN(cond, bar) do { unsigned _sp = 0; while (cond) { __builtin_amdgcn_s_sleep(1); \
    if ((++_sp & 255u) == 0u) { if (xb_ld(&(bar)[XB_TMO])) break; if (_sp > XB_SPIN_CAP) { atomicAdd(&(bar)[XB_TMO], 1u); break; } } } } while (0)

struct XcdBarrier {
    unsigned* bar; unsigned x;
    volatile LAS unsigned* st;
};

__device__ __forceinline__ XcdBarrier xcd_barrier_post(unsigned* bar, volatile LAS unsigned* st) {
    XcdBarrier b; b.bar = bar; b.x = xb_xcc_id(); b.st = st;
    if (threadIdx.x == 0) (void)xb_add(&bar[XB_XCNT(b.x)], 1u);
    return b;
}
__device__ __forceinline__ void xcd_barrier_complete(unsigned* bar, unsigned x, unsigned& nloc, unsigned& nx) {
    const unsigned G = gridDim.x * gridDim.y * gridDim.z;
    unsigned sum, cnt, mine, sp = 0u;
    for (;;) {
        sum = 0u; cnt = 0u; mine = 0u;
#pragma unroll
        for (unsigned j = 0; j < 16; ++j) { const unsigned c = xb_ld(&bar[XB_XCNT(j)]); sum += c; cnt += (c > 0u) ? 1u : 0u; mine = (j == x) ? c : mine; }
        if (sum == G) break;
        __builtin_amdgcn_s_sleep(1);
        if ((++sp & 255u) == 0u) { if (xb_ld(&bar[XB_TMO])) break; if (sp > XB_SPIN_CAP) { atomicAdd(&bar[XB_TMO], 1u); break; } }
    }
    nloc = mine > 0u ? mine : 1u; nx = cnt > 0u ? cnt : 1u;
}

__device__ __forceinline__ void xcd_barrier(const XcdBarrier& b) {
    asm volatile("s_waitcnt vmcnt(0)" ::: "memory");
    __syncthreads();
    if (threadIdx.x == 0) {
        unsigned* bar = b.bar;
        __builtin_amdgcn_s_waitcnt(0);
        unsigned nloc = b.st[0], nx = b.st[1];
        if (nloc == 0u) { xcd_barrier_complete(bar, b.x, nloc, nx); b.st[0] = nloc; b.st[1] = nx; }
        const unsigned old = xb_add(&bar[XB_XSUB(b.x)], 1u);
        const unsigned gen = old / nloc;
        if (old + 1u == (gen + 1u) * nloc) {
            __builtin_amdgcn_fence(__ATOMIC_RELEASE, "agent");
            asm volatile("s_waitcnt vmcnt(0)" ::: "memory");
            const unsigned og = xb_add(&bar[XB_TOP], 1u);
            const unsigned tg = og / nx;
            if (og + 1u == (tg + 1u) * nx) xb_add(&bar[XB_TOPGEN], 1u);
            else XB_SPIN(xb_ld(&bar[XB_TOPGEN]) == tg, bar);
            __builtin_amdgcn_fence(__ATOMIC_ACQUIRE, "agent");
            xb_add(&bar[XB_XGEN(b.x)], 1u);
            asm volatile("s_waitcnt vmcnt(0)" ::: "memory");
        } else {
            XB_SPIN(xb_ld(&bar[XB_XGEN(b.x)]) == gen, bar);
            __builtin_amdgcn_fence(__ATOMIC_ACQUIRE, "agent");
            asm volatile("s_waitcnt vmcnt(0)" ::: "memory");
        }
    }
    __syncthreads();
}
constexpr int NWAVES = 8;
constexpr int NTOK = 32768, DM = 4096, NIN = 25088, N_A = 12800, N_B = 12288, WA = 2048, CSH = 6656, SEQP = 4096, SEQS = 16384;
constexpr size_t MiB = 1u << 20;
constexpr size_t WS_CTL = 0, CTL_ZERO_BYTES = 1 * MiB;
constexpr size_t WS_ROPE = 2 * MiB;
constexpr size_t WS_LORA = 6 * MiB;
constexpr size_t WS_BONUS = 8 * MiB;
constexpr size_t WS_PART = 16 * MiB;
constexpr size_t WS_WOA = 24 * MiB, WS_WOB = 40 * MiB, WS_WOUT = 56 * MiB;
constexpr size_t WS_WIN = 88 * MiB;
constexpr size_t WS_H = 284 * MiB;
constexpr size_t WS_Q = 540 * MiB, WS_K = 668 * MiB, WS_V = 796 * MiB;
constexpr size_t WS_SLAB = 924 * MiB;
constexpr size_t WS_YB = 1340 * MiB;
constexpr size_t WS_LIN = 1468 * MiB;
constexpr size_t WS_END = 1500 * MiB;
constexpr size_t WS_M = WS_SLAB;
constexpr int CW_QUEUE = 64;
constexpr int CW_POS = 1024;
constexpr int CW_BAR = 4096;
constexpr int RING_OFF = 0, RING_BYTES = 143360;
constexpr int MISC_OFF = RING_BYTES;
constexpr int LDS_BYTES = 147456;

struct Frame {
    LAS unsigned char* lds;
    volatile LAS unsigned* MISC;
    gu32* ctl;
    int tid, lane, wave, vcu, G;
};
__device__ __forceinline__ float wave_sum(float v) {
    v += shx<1>(v); v += shx<2>(v); v += shx<4>(v); v += shx<8>(v); v += shx<16>(v); v += shx<32>(v);
    return v;
}
__device__ __forceinline__ float bf2f(bf16 b) { return __builtin_bit_cast(float, (unsigned)b << 16); }

__device__ __forceinline__ void p0_transpose_item(const float* W, int K, int N, bf16* WT, LAS float* scr, int item, int lane, bool permqk) {
    const int nblk = N / 32, kb = item / nblk, nb = item % nblk, k0 = 64 * kb, n0 = 32 * nb;
    int nsrc = n0 + (lane & 31);
    if (permqk && n0 < 4096) { const int dp = nsrc & 63; nsrc = (nsrc & ~63) + ((dp & 1) ? 32 + (dp >> 1) : (dp >> 1)); }
#pragma unroll 8
    for (int i = 0; i < 32; ++i) { const int kk = 2 * i + (lane >> 5); scr[kk * 33 + (lane & 31)] = W[(size_t)(k0 + kk) * N + nsrc]; }
    LDS_WAIT(); asm volatile("" ::: "memory");
    const int c = lane & 7;
#pragma unroll
    for (int j = 0; j < 4; ++j) { const int n = (lane >> 3) + 8 * j; const LAS float* s = scr + (8 * c) * 33 + n;
        v4u o; o.x = pk2(s[0 * 33], s[1 * 33]); o.y = pk2(s[2 * 33], s[3 * 33]); o.z = pk2(s[4 * 33], s[5 * 33]); o.w = pk2(s[6 * 33], s[7 * 33]);
        *(GAS v4u*)(WT + (size_t)(n0 + n) * K + k0 + 8 * c) = o; }
    LDS_WAIT(); asm volatile("" ::: "memory");
}
__device__ __forceinline__ void rms_row_to_bf16(const float* xrow, const float* g, bf16* orow, int lane) {
    const GAS f32x4* xr = (const GAS f32x4*)xrow + lane; const GAS f32x4* gr = (const GAS f32x4*)g + lane;
    f32x4 v[16]; float s = 0.f;
#pragma unroll
    for (int j = 0; j < 16; ++j) { v[j] = xr[64 * j]; s += (v[j].x * v[j].x + v[j].y * v[j].y) + (v[j].z * v[j].z + v[j].w * v[j].w); }
    const float rs = 1.f / sqrtf(wave_sum(s) * (1.f / 4096.f) + 1e-6f);
    GAS unsigned long long* o8 = (GAS unsigned long long*)orow + lane;
#pragma unroll
    for (int j = 0; j < 16; ++j) { const f32x4 gg = gr[64 * j];
        o8[64 * j] = (unsigned long long)pk2(v[j].x * rs * gg.x, v[j].y * rs * gg.y) | ((unsigned long long)pk2(v[j].z * rs * gg.z, v[j].w * rs * gg.w) << 32); }
}
namespace att {
typedef short s16x4 __attribute__((ext_vector_type(4)));
typedef short v4i16_t __attribute__((ext_vector_type(4)));
typedef float f32x16 __attribute__((ext_vector_type(16)));
constexpr int ST_K2 = 8192, KV_SLOT = 16384, K_RING = 0, V_RING = 4 * KV_SLOT, NSTG = 4, ST_BYTES = 32768;
constexpr int X_OFF = 0, WSF_OFF = 8 * KV_SLOT;
constexpr float THR = 5.f;
__device__ __forceinline__ int crow(int r, int hi) { return (r & 3) + 8 * (r >> 2) + 4 * hi; }
__device__ __forceinline__ s16x4 vtr(const LAS unsigned char* p) { return __builtin_bit_cast(s16x4, __builtin_amdgcn_ds_read_tr16_b64_v4i16((LAS v4i16_t*)p)); }
#define ATT_WAITBAR() asm volatile("s_waitcnt vmcnt(0) lgkmcnt(0)\n\ts_barrier" ::: "memory")
__device__ __forceinline__ void qkt(f32x16& p0, f32x16& p1, const LAS unsigned char* kst, const bf16x8 (&qr)[4], const f32x16& negm) {
#pragma unroll
    for (int d0 = 0; d0 < 4; ++d0) {
        const bf16x8 a0 = *(const LAS bf16x8*)(kst + d0 * 2048), a1 = *(const LAS bf16x8*)(kst + d0 * 2048 + 512);
        if (d0 == 0) { p0 = __builtin_amdgcn_mfma_f32_32x32x16_bf16(a0, qr[0], negm, 0, 0, 0); p1 = __builtin_amdgcn_mfma_f32_32x32x16_bf16(a1, qr[0], negm, 0, 0, 0); }
        else { p0 = __builtin_amdgcn_mfma_f32_32x32x16_bf16(a0, qr[d0], p0, 0, 0, 0); p1 = __builtin_amdgcn_mfma_f32_32x32x16_bf16(a1, qr[d0], p1, 0, 0, 0); }
    }
}
template <int CTRL> __device__ __forceinline__ float adpp(float x) { return __builtin_bit_cast(float, __builtin_amdgcn_update_dpp(0, __builtin_bit_cast(int, x), CTRL, 0xf, 0xf, false)); }
__device__ __forceinline__ float asum16(float v) { v += adpp<0xB1>(v); v += adpp<0x4E>(v); v += adpp<0x141>(v); v += adpp<0x140>(v); return v; }
__device__ __forceinline__ float rowmax32(const f32x16& p0, const f32x16& p1) {
    float a = fmaxf(p0[0], p1[0]), b = fmaxf(p0[1], p1[1]);
#pragma unroll
    for (int r = 2; r < 16; r += 2) { a = fmaxf(a, fmaxf(p0[r], p1[r])); b = fmaxf(b, fmaxf(p0[r + 1], p1[r + 1])); }
    a = fmaxf(a, b);
    return fmaxf(a, shx<32>(a));
}

__device__ __forceinline__ void attn_unit(LAS unsigned char* lds, const bf16* Q, const bf16* K, const bf16* V, bf16* O, int rb, int Ls, int h, int q0, const LAS float* lamp, const float* subln_g) {
    int tid = threadIdx.x; asm volatile("" : "+v"(tid));
    const int lane = tid & 63, r32 = lane & 31, hi = lane >> 5; const int wid = __builtin_amdgcn_readfirstlane(tid >> 6);
    const int qg = wid >> 1, c = wid & 1;
    LAS float* wsf = (LAS float*)(lds + WSF_OFF) + wid * 64;
    bf16x8 qr[4];
    { const bf16* qp = Q + (size_t)(rb + q0 + qg * 32 + r32) * 2048 + h * 128 + c * 64 + hi * 8;
#pragma unroll
      for (int d0 = 0; d0 < 4; ++d0) qr[d0] = *(const bf16x8*)(qp + d0 * 16); }
    const bf16* src[4]; int dsto[4];
#pragma unroll
    for (int i = 0; i < 4; ++i) { const int p = wid * 4 + i;
        if (p < 16) { src[i] = K + (((((size_t)(rb >> 6) * 16 + h) * 2 + (p >> 3)) * 8 + (p & 7)) * 64 + lane) * 8; dsto[i] = K_RING + (p < 8 ? 0 : ST_K2) + (p & 7) * 1024; }
        else { const int v = p - 16; src[i] = V + (((size_t)(rb >> 6) * 16 + h) * 16 + v) * 512 + lane * 8; dsto[i] = V_RING + v * 1024; } }
#define ATT_DMA(t) do { _Pragma("unroll") for (int i_ = 0; i_ < 4; ++i_) { unsigned keep_; const bf16* g_ = src[i_] + (size_t)(t) * 64 * 2048; const unsigned l_ = (unsigned)(size_t)(lds + ((t) & 3) * KV_SLOT + dsto[i_]); \
        asm volatile("s_mov_b32 %0, m0\n\ts_mov_b32 m0, %2\n\ts_nop 0\n\tglobal_load_lds_dwordx4 %1, off\n\ts_mov_b32 m0, %0" : "=&s"(keep_) : "v"(g_), "s"(l_) : "memory"); } } while (0)
    const int NT = Ls / 64;
    const bool kwave = wid < 4;
    ATT_DMA(0); ATT_DMA(1); if (kwave) ATT_DMA(2);
    f32x16 o[4];
#pragma unroll
    for (int d = 0; d < 4; ++d) o[d] = (f32x16){};
    const int koff = K_RING + (c ? ST_K2 : 0) + hi * 1024 + r32 * 16;
    const int voff = V_RING + (4 * hi + ((lane & 15) >> 2)) * 64 + ((lane >> 4) & 1) * 32 + (lane & 3) * 8;
    if (kwave) asm volatile("s_waitcnt vmcnt(8) lgkmcnt(0)\n\ts_barrier" ::: "memory"); else asm volatile("s_waitcnt vmcnt(4) lgkmcnt(0)\n\ts_barrier" ::: "memory");
    f32x16 pc0, pc1, pn0, pn1, negm = (f32x16){}; asm volatile("" : "+v"(negm));
    qkt(pc0, pc1, lds + koff, qr, negm);
    float m_run = rowmax32(pc0, pc1), l_run = 0.f;
#pragma unroll
    for (int r = 0; r < 16; ++r) { pc0[r] -= m_run; pc1[r] -= m_run; negm[r] = -m_run; }
    asm volatile("" : "+v"(negm));
    u32x4 pw[4];
#define ATT_LOADV(L, H, d) do { _Pragma("unroll") for (int ks_ = 0; ks_ < 4; ++ks_) { L[ks_] = vtr(st + ((d) * 4 + ks_) * 1024); H[ks_] = vtr(st + ((d) * 4 + ks_) * 1024 + 512); } } while (0)
#define ATT_PV1(d, L, H) do { _Pragma("unroll") for (int ks_ = 0; ks_ < 4; ++ks_) { const bf16x8 vf_ = (bf16x8){L[ks_][0], L[ks_][1], L[ks_][2], L[ks_][3], H[ks_][0], H[ks_][1], H[ks_][2], H[ks_][3]}; \
            o[d] = __builtin_amdgcn_mfma_f32_32x32x16_bf16(__builtin_bit_cast(bf16x8, pw[ks_]), vf_, o[d], 0, 0, 0); } } while (0)
#define ATT_SGB(m, n) __builtin_amdgcn_sched_group_barrier((m), (n), 0)
#define ATT_PV(stage_off) do { const LAS unsigned char* st = lds + (stage_off) + voff; s16x4 la[4], ha[4], lb[4], hb[4]; __builtin_amdgcn_sched_barrier(0); \
        ATT_LOADV(la, ha, 0); ATT_LOADV(lb, hb, 1); ATT_PV1(0, la, ha); ATT_LOADV(la, ha, 2); ATT_PV1(1, lb, hb); ATT_LOADV(lb, hb, 3); ATT_PV1(2, la, ha); ATT_PV1(3, lb, hb); \
        ATT_SGB(0x100, 16); ATT_SGB(0x8, 4); ATT_SGB(0x100, 8); ATT_SGB(0x8, 4); ATT_SGB(0x100, 8); ATT_SGB(0x8, 8); __builtin_amdgcn_sched_barrier(0); } while (0)
#define ATT_STEP(PC0, PC1, PN0, PN1, t, CHECK, FIRST) do { \
          \
        if (FIRST) { ATT_WAITBAR(); \
            if (kwave) { if ((t) + 3 < NT) ATT_DMA((t) + 3); if ((t) + 4 < NT) ATT_DMA((t) + 4); } else { if ((t) + 2 < NT) { ATT_DMA((t) + 2); ATT_DMA((t) + 3); } } } \
        const bool has_next = (t) + 1 < NT; \
        if (has_next) qkt(PN0, PN1, lds + (((t) + 1) & 3) * KV_SLOT + koff, qr, negm); \
          \
        const float rm = (CHECK) ? rowmax32(PC0, PC1) : 0.f; \
        if ((CHECK) && __any(rm > THR)) {                             \
            const float dl = fmaxf(rm, 0.f); m_run += dl; const float alpha = __builtin_amdgcn_exp2f(-dl); l_run *= alpha; \
            _Pragma("unroll") for (int r = 0; r < 16; ++r) { PC0[r] -= dl; PC1[r] -= dl; negm[r] = -m_run; } \
            asm volatile("" : "+v"(negm)); \
            if (has_next) { _Pragma("unroll") for (int r = 0; r < 16; ++r) { PN0[r] -= dl; PN1[r] -= dl; } } \
            if (hi == 0) wsf[r32] = alpha; \
            asm volatile("s_waitcnt lgkmcnt(0)" ::: "memory"); \
            _Pragma("unroll") for (int r = 0; r < 16; ++r) { const float a_ = wsf[crow(r, hi)]; _Pragma("unroll") for (int d = 0; d < 4; ++d) o[d][r] *= a_; } \
        } \
        float ls0 = 0.f, ls1 = 0.f; \
        _Pragma("unroll") for (int r = 0; r < 16; ++r) { PC0[r] = __builtin_amdgcn_exp2f(PC0[r]); PC1[r] = __builtin_amdgcn_exp2f(PC1[r]); ls0 += PC0[r]; ls1 += PC1[r]; } \
        l_run += ls0 + ls1; \
          \
        pw[0] = (u32x4){pg8::cvt_pk_bf16(PC0[0], PC0[1]), pg8::cvt_pk_bf16(PC0[2], PC0[3]), pg8::cvt_pk_bf16(PC0[4], PC0[5]), pg8::cvt_pk_bf16(PC0[6], PC0[7])}; \
        pw[1] = (u32x4){pg8::cvt_pk_bf16(PC0[8], PC0[9]), pg8::cvt_pk_bf16(PC0[10], PC0[11]), pg8::cvt_pk_bf16(PC0[12], PC0[13]), pg8::cvt_pk_bf16(PC0[14], PC0[15])}; \
        pw[2] = (u32x4){pg8::cvt_pk_bf16(PC1[0], PC1[1]), pg8::cvt_pk_bf16(PC1[2], PC1[3]), pg8::cvt_pk_bf16(PC1[4], PC1[5]), pg8::cvt_pk_bf16(PC1[6], PC1[7])}; \
        pw[3] = (u32x4){pg8::cvt_pk_bf16(PC1[8], PC1[9]), pg8::cvt_pk_bf16(PC1[10], PC1[11]), pg8::cvt_pk_bf16(PC1[12], PC1[13]), pg8::cvt_pk_bf16(PC1[14], PC1[15])}; \
        ATT_PV(((t) & 3) * KV_SLOT); } while (0)
    for (int t = 0; t < NT; t += 2) { ATT_STEP(pc0, pc1, pn0, pn1, t, (t & 6) == 0, true); ATT_STEP(pn0, pn1, pc0, pc1, t + 1, false, false); }
#undef ATT_LOADV
#undef ATT_PV1
#undef ATT_PV
#undef ATT_SGB
#undef ATT_STEP
    l_run += shx<32>(l_run);
    if (hi == 0) wsf[r32] = (c ? *lamp : 1.f) / l_run;
    ATT_WAITBAR();
    LAS float* X = (LAS float*)(lds + X_OFF) + qg * 4096;
    float sc[16];
#pragma unroll
    for (int r = 0; r < 16; ++r) sc[r] = wsf[crow(r, hi)];
    if (c == 1) {
#pragma unroll
        for (int d = 0; d < 4; ++d)
#pragma unroll
            for (int r = 0; r < 16; ++r) X[(d * 16 + r) * 64 + lane] = o[d][r] * sc[r];
    }
    ATT_WAITBAR();
    if (c == 0) {
        float ss[16];
#pragma unroll
        for (int r = 0; r < 16; ++r) { float s = 0.f;
#pragma unroll
            for (int d = 0; d < 4; ++d) { const float y = o[d][r] * sc[r] - X[(d * 16 + r) * 64 + lane]; o[d][r] = y; s += y * y; }
            ss[r] = s; }
#pragma unroll
        for (int r = 0; r < 16; ++r) ss[r] = asum16(ss[r]);
        float sx[16];
#pragma unroll
        for (int r = 0; r < 16; ++r) sx[r] = shx<16>(ss[r]);
        __builtin_amdgcn_sched_barrier(0);
#pragma unroll
        for (int r = 0; r < 16; ++r) ss[r] = 0.8f * __builtin_amdgcn_rsqf((ss[r] + sx[r]) * (1.f / 128.f) + 1e-5f);
        float g[4];
#pragma unroll
        for (int d = 0; d < 4; ++d) g[d] = subln_g[32 * d + r32];
#pragma unroll
        for (int r = 0; r < 16; ++r) { bf16* op = O + (size_t)(rb + q0 + qg * 32 + crow(r, hi)) * 2048 + h * 128 + r32;
#pragma unroll
            for (int d = 0; d < 4; ++d) op[32 * d] = (bf16)f2bf(o[d][r] * ss[r] * g[d]); }
    }
    ATT_WAITBAR();
#undef ATT_DMA
}
}
namespace scan1 {
constexpr int O_W = 0, O_KK = 16384, O_B = 32768, O_KD = 49152, O_R = 65536, O_V = 81920, O_TW = 98304, O_PA = 98304 + 17408, TWS = 136;
struct P { const bf16* SL; const float *mu_prev, *mu_next, *w0, *a0, *k_k, *k_a, *r_k; const bf16* LT; float* YD; float* BON; };
__device__ __forceinline__ void ld8(const bf16* p, bool ok, float (&v)[8]) {
    u32x4 w = ok ? *(const u32x4*)p : (u32x4){0u, 0u, 0u, 0u};
    v[0] = pg8::bflo(w.x); v[1] = pg8::bfhi(w.x); v[2] = pg8::bflo(w.y); v[3] = pg8::bfhi(w.y); v[4] = pg8::bflo(w.z); v[5] = pg8::bfhi(w.z); v[6] = pg8::bflo(w.w); v[7] = pg8::bfhi(w.w);
}
__device__ __forceinline__ void shift8(const P& a, int rb, int Ls, int tok, int col, float (&x)[8]) {
    const bf16* rp = a.SL + (size_t)(rb + tok) * CSH + col; float pc[8], pp[8], pn[8];
    ld8(rp, true, pc); ld8(rp - CSH, tok > 0, pp); ld8(rp + CSH, tok < Ls - 1, pn);
    const f32x4 m0 = *(const f32x4*)(a.mu_prev + col), m1 = *(const f32x4*)(a.mu_prev + col + 4), n0 = *(const f32x4*)(a.mu_next + col), n1 = *(const f32x4*)(a.mu_next + col + 4);
#pragma unroll
    for (int i = 0; i < 8; ++i) { const float mp = i < 4 ? m0[i] : m1[i - 4], mn = i < 4 ? n0[i] : n1[i - 4]; x[i] = pc[i] + mp * (pp[i] - pc[i]) + mn * (pn[i] - pc[i]); }
}
__device__ __forceinline__ void scan_item(Frame& F, const P& a, int seq, int h, int dir) {
    const int rb = seq < 4 ? seq * SEQP : 4 * SEQP, Ls = seq < 4 ? SEQP : SEQS, nch = Ls / 64;
    LAS unsigned char* lds = F.lds;
    LAS float *Wd = (LAS float*)(lds + O_W), *KKs = (LAS float*)(lds + O_KK), *Bs = (LAS float*)(lds + O_B), *KDs = (LAS float*)(lds + O_KD), *Rs = (LAS float*)(lds + O_R), *Vs = (LAS float*)(lds + O_V);
    LAS bf16 *TW = (LAS bf16*)(lds + O_TW), *PA = (LAS bf16*)(lds + O_PA);
    int tid0 = F.tid; asm volatile("" : "+v"(tid0));
    float st[64];
#pragma unroll
    for (int j = 0; j < 64; ++j) st[j] = 0.f;
    for (int ci = 0; ci < nch; ++ci) {
        int tid = tid0; asm volatile("" : "+v"(tid));
        const int lane = tid & 63, wid = __builtin_amdgcn_readfirstlane(tid >> 6);
        { const int s = tid >> 3, c8 = (tid & 7) * 8, tok = dir ? (Ls - 1 - 64 * ci - s) : (64 * ci + s), ch = h * 64 + c8;
          float xr[8], xk[8], xv[8]; shift8(a, rb, Ls, tok, ch, xr); asm volatile("" ::: "memory"); shift8(a, rb, Ls, tok, 2048 + ch, xk); asm volatile("" ::: "memory"); shift8(a, rb, Ls, tok, 4096 + ch, xv); asm volatile("" ::: "memory");
          float kk[8], ss = 0.f;
#pragma unroll
          for (int i = 0; i < 8; ++i) { kk[i] = xk[i] * a.k_k[ch + i]; ss += kk[i] * kk[i]; }
          ss += shx<1>(ss); ss += shx<2>(ss); ss += shx<4>(ss);
          const float inv = 1.f / fmaxf(sqrtf(ss), 1e-12f);
#pragma unroll
          for (int i = 0; i < 8; ++i) { Rs[s * 64 + c8 + i] = xr[i]; Vs[s * 64 + c8 + i] = xv[i]; KDs[s * 64 + c8 + i] = xk[i]; KKs[s * 64 + c8 + i] = kk[i] * inv; } }
        asm volatile("" ::: "memory");
        { const int s = tid >> 3, c16 = (tid & 7) * 16, tok = dir ? (Ls - 1 - 64 * ci - s) : (64 * ci + s);
#pragma unroll
          for (int hf = 0; hf < 2; ++hf) { asm volatile("" ::: "memory"); float xw[8], xa[8]; shift8(a, rb, Ls, tok, 6144 + dir * 128 + c16 + hf * 8, xw); asm volatile("" ::: "memory"); shift8(a, rb, Ls, tok, 6400 + dir * 128 + c16 + hf * 8, xa);
#pragma unroll
              for (int i = 0; i < 8; ++i) { TW[s * TWS + c16 + hf * 8 + i] = (bf16)f2bf(tanhf(xw[i])); PA[s * TWS + c16 + hf * 8 + i] = (bf16)f2bf(xa[i]); } } }
        __syncthreads();
        { const int tm = wid >> 1, fr = lane & 15, fq = lane >> 4;
#pragma unroll
          for (int tt = 0; tt < 2; ++tt) { const int tn = (wid & 1) * 2 + tt; f32x4 aw = (f32x4){0.f, 0.f, 0.f, 0.f}, aa = (f32x4){0.f, 0.f, 0.f, 0.f};
              const bf16* bw = a.LT + ((size_t)(0 * 2 + dir) * 2048 + h * 64 + tn * 16 + fr) * 128 + fq * 8;
              const bf16* ba = a.LT + ((size_t)(1 * 2 + dir) * 2048 + h * 64 + tn * 16 + fr) * 128 + fq * 8;
#pragma unroll
              for (int ks = 0; ks < 4; ++ks) {
                  const bf16x8 fa_w = *(const LAS bf16x8*)(TW + (tm * 16 + fr) * TWS + ks * 32 + fq * 8), fa_a = *(const LAS bf16x8*)(PA + (tm * 16 + fr) * TWS + ks * 32 + fq * 8);
                  const bf16x8 fb_w = *(const bf16x8*)(bw + ks * 32), fb_a = *(const bf16x8*)(ba + ks * 32);
                  aw = __builtin_amdgcn_mfma_f32_16x16x32_bf16(fa_w, fb_w, aw, 0, 0, 0);
                  aa = __builtin_amdgcn_mfma_f32_16x16x32_bf16(fa_a, fb_a, aa, 0, 0, 0); }
              const int n = tn * 16 + fr, chn = h * 64 + n; const float w0v = a.w0[dir * 2048 + chn], a0v = a.a0[dir * 2048 + chn], kav = a.k_a[chn];
#pragma unroll
              for (int i = 0; i < 4; ++i) { const int s = tm * 16 + fq * 4 + i; const float wl = w0v + aw[i], al = a0v + aa[i];
                  const float sp = (-wl > 20.f) ? -wl : log1pf(__expf(-wl));
                  const float dec = __expf(-__expf(-sp - 0.5f)); const float av = 1.f / (1.f + __expf(-al));
                  const float kraw = KDs[s * 64 + n], kkv = KKs[s * 64 + n];
                  Wd[s * 64 + n] = dec; KDs[s * 64 + n] = kraw * (1.f + (av - 1.f) * kav); Bs[s * 64 + n] = kkv * av; } } }
        __syncthreads();
        { const int s = tid >> 3, c8 = (tid & 7) * 8, tok = dir ? (Ls - 1 - 64 * ci - s) : (64 * ci + s); float bs = 0.f;
#pragma unroll
          for (int i = 0; i < 8; ++i) bs += Rs[s * 64 + c8 + i] * KDs[s * 64 + c8 + i] * a.r_k[h * 64 + c8 + i];
          bs += shx<1>(bs); bs += shx<2>(bs); bs += shx<4>(bs);
          if ((tid & 7) == 0) a.BON[((size_t)dir * NTOK + rb + tok) * 32 + h] = bs; }
        if (wid == 0) {
            for (int s = 0; s < 64; ++s) { const int tok = dir ? (Ls - 1 - 64 * ci - s) : (64 * ci + s);
                const LAS float *kkp = KKs + s * 64, *wp = Wd + s * 64, *bp = Bs + s * 64, *kdp = KDs + s * 64, *rp = Rs + s * 64; const float vi = Vs[s * 64 + lane];
                float sa0 = 0.f, sa1 = 0.f;
#pragma unroll
                for (int jb = 0; jb < 64; jb += 8) { const f32x4 k0 = *(const LAS f32x4*)(kkp + jb), k1 = *(const LAS f32x4*)(kkp + jb + 4);
                    sa0 += st[jb] * k0[0]; sa1 += st[jb + 1] * k0[1]; sa0 += st[jb + 2] * k0[2]; sa1 += st[jb + 3] * k0[3];
                    sa0 += st[jb + 4] * k1[0]; sa1 += st[jb + 5] * k1[1]; sa0 += st[jb + 6] * k1[2]; sa1 += st[jb + 7] * k1[3];
                    asm volatile("" ::: "memory"); }
                const float sa = -(sa0 + sa1); float y0 = 0.f, y1 = 0.f;
#pragma unroll
                for (int jb = 0; jb < 64; jb += 4) { const f32x4 w4 = *(const LAS f32x4*)(wp + jb), b4 = *(const LAS f32x4*)(bp + jb), d4 = *(const LAS f32x4*)(kdp + jb), r4 = *(const LAS f32x4*)(rp + jb);
#pragma unroll
                    for (int q = 0; q < 4; ++q) { st[jb + q] = st[jb + q] * w4[q] + sa * b4[q] + vi * d4[q]; }
                    y0 += st[jb] * r4[0]; y1 += st[jb + 1] * r4[1]; y0 += st[jb + 2] * r4[2]; y1 += st[jb + 3] * r4[3];
                    asm volatile("" ::: "memory"); }
                a.YD[((size_t)dir * NTOK + rb + tok) * 2048 + h * 64 + lane] = y0 + y1; }
        }
        __syncthreads();
    }
}
__device__ __forceinline__ float fsum16(float v) {
    v += __builtin_bit_cast(float, __builtin_amdgcn_update_dpp(0, __builtin_bit_cast(int, v), 0xB1, 0xf, 0xf, false)); v += __builtin_bit_cast(float, __builtin_amdgcn_update_dpp(0, __builtin_bit_cast(int, v), 0x4E, 0xf, 0xf, false));
    v += __builtin_bit_cast(float, __builtin_amdgcn_update_dpp(0, __builtin_bit_cast(int, v), 0x141, 0xf, 0xf, false)); v += __builtin_bit_cast(float, __builtin_amdgcn_update_dpp(0, __builtin_bit_cast(int, v), 0x140, 0xf, 0xf, false)); return v; }
__device__ __forceinline__ void finalize(Frame& F, const P& a, const float* lnx_g, const float* lnx_b, bf16* YB) {
    const int gw = F.vcu * NWAVES + F.wave, NGW = F.G * NWAVES, lane = F.lane;
    LAS float* PRM = (LAS float*)F.lds;
    for (int i = F.tid; i < 2048; i += NWAVES * 64) { PRM[i] = a.mu_prev[4096 + i]; PRM[2048 + i] = a.mu_next[4096 + i]; PRM[4096 + i] = lnx_g[i]; PRM[6144 + i] = lnx_b[i]; }
    __syncthreads();
    for (int row = gw; row < NTOK; row += NGW) { const int seqrow = row < 4 * SEQP ? (row & (SEQP - 1)) : (row - 4 * SEQP), Ls = row < 4 * SEQP ? SEQP : SEQS;
        const bool okp = seqrow > 0, okn = seqrow < Ls - 1; const int rowp = okp ? row - 1 : row, rown = okn ? row + 1 : row;
#pragma unroll 1
        for (int hb = 0; hb < 2; ++hb) {
        uint2 yf[4], yb[4]; uint2 pc[4], pp[4], pn[4]; float bon[4];
#pragma unroll
        for (int it = 0; it < 4; ++it) { const int c = (hb * 4 + it) * 256 + lane * 4, h = c >> 6;
            yf[it] = *(const uint2*)((const bf16*)a.YD + (size_t)row * 2048 + c); yb[it] = *(const uint2*)((const bf16*)a.YD + ((size_t)NTOK + row) * 2048 + c);
            pc[it] = *(const uint2*)(a.SL + (size_t)row * CSH + 4096 + c); pp[it] = *(const uint2*)(a.SL + (size_t)rowp * CSH + 4096 + c); pn[it] = *(const uint2*)(a.SL + (size_t)rown * CSH + 4096 + c);
            bon[it] = a.BON[(size_t)row * 32 + h] + a.BON[((size_t)NTOK + row) * 32 + h]; }
#pragma unroll
        for (int it = 0; it < 4; ++it) { const int c = (hb * 4 + it) * 256 + lane * 4;
            f32x4 y = (f32x4){pg8::bflo(yf[it].x) + pg8::bflo(yb[it].x), pg8::bfhi(yf[it].x) + pg8::bfhi(yb[it].x), pg8::bflo(yf[it].y) + pg8::bflo(yb[it].y), pg8::bfhi(yf[it].y) + pg8::bfhi(yb[it].y)}; float s = (y.x + y.y) + (y.z + y.w);
            s = fsum16(s);
            const float mu = s * (1.f / 64.f); y = y - mu; float q = (y.x * y.x + y.y * y.y) + (y.z * y.z + y.w * y.w);
            q = fsum16(q);
            const float rs = 1.f / sqrtf(q * (1.f / 64.f) + 64e-5f);
            const uint2 ppv = okp ? pp[it] : make_uint2(0u, 0u), pnv = okn ? pn[it] : make_uint2(0u, 0u);
            const f32x4 mp = *(const LAS f32x4*)(PRM + c), mn = *(const LAS f32x4*)(PRM + 2048 + c), g = *(const LAS f32x4*)(PRM + 4096 + c), b = *(const LAS f32x4*)(PRM + 6144 + c);
            const float c0 = pg8::bflo(pc[it].x), c1 = pg8::bfhi(pc[it].x), c2 = pg8::bflo(pc[it].y), c3 = pg8::bfhi(pc[it].y);
            const float v0 = c0 + mp.x * (pg8::bflo(ppv.x) - c0) + mn.x * (pg8::bflo(pnv.x) - c0), v1 = c1 + mp.y * (pg8::bfhi(ppv.x) - c1) + mn.y * (pg8::bfhi(pnv.x) - c1);
            const float v2 = c2 + mp.z * (pg8::bflo(ppv.y) - c2) + mn.z * (pg8::bflo(pnv.y) - c2), v3 = c3 + mp.w * (pg8::bfhi(ppv.y) - c3) + mn.w * (pg8::bfhi(pnv.y) - c3);
            uint2 o; o.x = pk2(y.x * rs * g.x + b.x + bon[it] * v0, y.y * rs * g.y + b.y + bon[it] * v1); o.y = pk2(y.z * rs * g.z + b.z + bon[it] * v2, y.w * rs * g.w + b.w + bon[it] * v3);
            *(uint2*)(YB + (size_t)row * 2048 + c) = o; } }
    }
    __syncthreads();
}
}
namespace scan2 {
constexpr int LDJ = 72, LDT = 40;
constexpr int O_KKT = 0, O_RT = 4608, O_KB = 9216, O_BB = 13824, O_VB = 18432, O_TW = 23040, O_PA = 31744, TWS = 136;
constexpr int O_RF = 40448, O_KDF = 48640, O_KKF = 56832, O_BF = 65024, O_LW = 73216;
constexpr int O_MAK = 81408, O_MRK = 83968, O_MRB = 86528, O_NB = 89088, O_NF = 91648, O_TM = 95872, O_PB = 98432, O_RHST = 100992, O_SAT = 106112, O_SC = 111232, O_GL = 120448, O_END = 120704;
static_assert(O_END <= RING_BYTES, "scan2 LDS map");
typedef unsigned u32x2 __attribute__((ext_vector_type(2)));
typedef short s16x4 __attribute__((ext_vector_type(4)));
typedef short v4i16_t __attribute__((ext_vector_type(4)));
using scan1::P; using scan1::ld8;
__device__ __forceinline__ void ld4(const bf16* p, bool ok, float (&v)[4]) { const uint2 w = ok ? *(const uint2*)p : make_uint2(0u, 0u); v[0] = pg8::bflo(w.x); v[1] = pg8::bfhi(w.x); v[2] = pg8::bflo(w.y); v[3] = pg8::bfhi(w.y); }
__device__ __forceinline__ void shift4(const P& a, int rb, int Ls, int tok, int col, float (&x)[4]) {
    const bf16* rp = a.SL + (size_t)(rb + tok) * CSH + col; float pc[4], pp[4], pn[4];
    ld4(rp, true, pc); ld4(rp - CSH, tok > 0, pp); ld4(rp + CSH, tok < Ls - 1, pn);
    const f32x4 m0 = *(const f32x4*)(a.mu_prev + col), n0 = *(const f32x4*)(a.mu_next + col);
#pragma unroll
    for (int i = 0; i < 4; ++i) x[i] = pc[i] + m0[i] * (pp[i] - pc[i]) + n0[i] * (pn[i] - pc[i]);
}
__device__ __forceinline__ bf16x8 rowfrag(const LAS unsigned char* base, int ldb, int x0, int k0, int lane) {
    return *(const LAS bf16x8*)(base + (x0 + (lane & 15)) * ldb + (k0 + 8 * (lane >> 4)) * 2);
}
__device__ __forceinline__ bf16x8 trfrag(const LAS unsigned char* base, int ldb, int x0, int k0, int lane) {
    const LAS unsigned char* p = base + (k0 + 8 * (lane >> 4) + ((lane & 15) >> 2)) * ldb + (x0 + 4 * (lane & 3)) * 2;
    const s16x4 lo = __builtin_bit_cast(s16x4, __builtin_amdgcn_ds_read_tr16_b64_v4i16((LAS v4i16_t*)p));
    const s16x4 hi = __builtin_bit_cast(s16x4, __builtin_amdgcn_ds_read_tr16_b64_v4i16((LAS v4i16_t*)(p + 4 * ldb)));
    return (bf16x8){lo[0], lo[1], lo[2], lo[3], hi[0], hi[1], hi[2], hi[3]};
}
#define MF16(a, b, c) __builtin_amdgcn_mfma_f32_16x16x32_bf16((a), (b), (c), 0, 0, 0)
__device__ __forceinline__ void store_ct(LAS unsigned char* base, int ldb, int n0, int m0, int lane, f32x4 c) {
    u32x2 w; w.x = pg8::cvt_pk_bf16(c[0], c[1]); w.y = pg8::cvt_pk_bf16(c[2], c[3]);
    *(LAS u32x2*)(base + (n0 + (lane & 15)) * ldb + (m0 + 4 * (lane >> 4)) * 2) = w;
}
constexpr int O_MU = O_END, O_TOT = O_MU + 2 * 192 * 4, O_BP = O_TOT + 8 * 64 * 4, O_END2 = O_BP + 4 * 32 * 4;
static_assert(O_END2 <= RING_BYTES, "scan2 LDS map");
struct Raw { u32x2 rkv[3][3]; u32x4 pw, pa; };
__device__ __forceinline__ void load_raw(Raw& R, const P& a, const bf16* LIN, int rb, int Ls, int tok, int h, int dir, int c4, int c8) {
    const bf16* rp = a.SL + (size_t)(rb + tok) * CSH; const bool okp = tok > 0, okn = tok < Ls - 1;
#pragma unroll
    for (int g = 0; g < 3; ++g) { const bf16* p = rp + g * 2048 + h * 64 + c4;
        R.rkv[g][1] = *(const u32x2*)p; R.rkv[g][0] = okp ? *(const u32x2*)(p - CSH) : (u32x2){0u, 0u}; R.rkv[g][2] = okn ? *(const u32x2*)(p + CSH) : (u32x2){0u, 0u}; }
    const bf16* lp = LIN + (size_t)(rb + tok) * 512 + dir * 128 + c8; R.pw = *(const u32x4*)lp; R.pa = *(const u32x4*)(lp + 256);
}
__device__ __forceinline__ float sh1(unsigned pc, unsigned pp, unsigned pn, bool hi16, float mp, float mn) {
    const float c = hi16 ? pg8::bfhi(pc) : pg8::bflo(pc), p = hi16 ? pg8::bfhi(pp) : pg8::bflo(pp), n = hi16 ? pg8::bfhi(pn) : pg8::bflo(pn);
    return c + mp * (p - c) + mn * (n - c);
}
__device__ __forceinline__ bf16 tobf(float x) { return (bf16)(pg8::cvt_pk_bf16(x, 0.f) & 0xffffu); }
__device__ __forceinline__ float fast_tanh(float x) { return 1.f - 2.f * __builtin_amdgcn_rcpf(1.f + __builtin_amdgcn_exp2f(2.885390081777927f * x)); }
__device__ __forceinline__ void lora_inputs(Frame& F, const P& a, bf16* LIN) {
    for (int it = blockIdx.x * (NWAVES * 64) + F.tid; it < NTOK * 64; it += F.G * NWAVES * 64) { const int row = it >> 6, c8 = (it & 63) * 8;
        const int seqrow = row < 4 * SEQP ? (row & (SEQP - 1)) : (row - 4 * SEQP), Ls = row < 4 * SEQP ? SEQP : SEQS; float x[8];
        scan1::shift8(a, row - seqrow, Ls, seqrow, 6144 + c8, x);
        u32x4 w;
        if (c8 < 256) { w.x = pg8::cvt_pk_bf16(fast_tanh(x[0]), fast_tanh(x[1])); w.y = pg8::cvt_pk_bf16(fast_tanh(x[2]), fast_tanh(x[3])); w.z = pg8::cvt_pk_bf16(fast_tanh(x[4]), fast_tanh(x[5])); w.w = pg8::cvt_pk_bf16(fast_tanh(x[6]), fast_tanh(x[7])); }
        else { w.x = pg8::cvt_pk_bf16(x[0], x[1]); w.y = pg8::cvt_pk_bf16(x[2], x[3]); w.z = pg8::cvt_pk_bf16(x[4], x[5]); w.w = pg8::cvt_pk_bf16(x[6], x[7]); }
        *(u32x4*)(LIN + (size_t)row * 512 + c8) = w; }
}
__device__ __forceinline__ void scan_item(Frame& F, const P& a, const bf16* LIN, int seq, int h, int dir) {
    const int rb = seq < 4 ? seq * SEQP : 4 * SEQP, Ls = seq < 4 ? SEQP : SEQS, nch = Ls / 32;
    LAS unsigned char* lds = F.lds;
    int tid0 = F.tid; asm volatile("" : "+v"(tid0));
    for (int i = tid0; i < (O_SC + 9216 - O_TM) / 4; i += NWAVES * 64) { const int o = O_TM + 4 * i; if (o < O_RHST || o >= O_SC) *(LAS unsigned*)(lds + o) = 0u; }
    if (tid0 < 192) { const int col = (tid0 >> 6) * 2048 + h * 64 + (tid0 & 63); *((LAS float*)(lds + O_MU) + tid0) = a.mu_prev[col]; *((LAS float*)(lds + O_MU) + 192 + tid0) = a.mu_next[col]; }
    f32x4 st0 = (f32x4){0.f, 0.f, 0.f, 0.f}, st1 = (f32x4){0.f, 0.f, 0.f, 0.f};
    bf16x8 fbw[4], fba[4]; float w0v, a0v, kav, rkv; f32x4 kkw;
    { const int lane = tid0 & 63, wid = __builtin_amdgcn_readfirstlane(tid0 >> 6), fr = lane & 15, fq = lane >> 4, tn = wid & 3;
      const bf16* bw = a.LT + ((size_t)(0 * 2 + dir) * 2048 + h * 64 + tn * 16 + fr) * 128 + fq * 8;
      const bf16* ba = a.LT + ((size_t)(1 * 2 + dir) * 2048 + h * 64 + tn * 16 + fr) * 128 + fq * 8;
#pragma unroll
      for (int ks = 0; ks < 4; ++ks) { fbw[ks] = *(const bf16x8*)(bw + ks * 32); fba[ks] = *(const bf16x8*)(ba + ks * 32); }
      const int chn = h * 64 + tn * 16 + fr; w0v = a.w0[dir * 2048 + chn]; a0v = a.a0[dir * 2048 + chn]; kav = a.k_a[chn]; rkv = a.r_k[chn];
      kkw = *(const f32x4*)(a.k_k + h * 64 + (tid0 & 15) * 4); }
    Raw R;
    { const int t = tid0 >> 4; load_raw(R, a, LIN, rb, Ls, dir ? (Ls - 1 - t) : t, h, dir, (tid0 & 15) * 4, (tid0 & 15) * 8); }
    __syncthreads();
    for (int ci = 0; ci < nch; ++ci) {
        int tid = tid0; asm volatile("" : "+v"(tid));
        const int lane = tid & 63, wid = __builtin_amdgcn_readfirstlane(tid >> 6), fr = lane & 15, fq = lane >> 4;
        const int tbase = dir ? (Ls - 1 - 32 * ci) : 32 * ci, tsgn = dir ? -1 : 1;
        const int tm = wid >> 2, tn = wid & 3;
        { const int t = tid >> 4, c4 = (tid & 15) * 4, c8 = (tid & 15) * 8; const LAS float* MUP = (const LAS float*)(lds + O_MU); const LAS float* MUN = MUP + 192;
          float x[3][4];
#pragma unroll
          for (int g = 0; g < 3; ++g) { const f32x4 mp = *(const LAS f32x4*)(MUP + g * 64 + c4), mn = *(const LAS f32x4*)(MUN + g * 64 + c4);
              x[g][0] = sh1(R.rkv[g][1].x, R.rkv[g][0].x, R.rkv[g][2].x, false, mp[0], mn[0]); x[g][1] = sh1(R.rkv[g][1].x, R.rkv[g][0].x, R.rkv[g][2].x, true, mp[1], mn[1]);
              x[g][2] = sh1(R.rkv[g][1].y, R.rkv[g][0].y, R.rkv[g][2].y, false, mp[2], mn[2]); x[g][3] = sh1(R.rkv[g][1].y, R.rkv[g][0].y, R.rkv[g][2].y, true, mp[3], mn[3]); }
          float kk[4], ss = 0.f;
#pragma unroll
          for (int i = 0; i < 4; ++i) { kk[i] = x[1][i] * kkw[i]; ss += kk[i] * kk[i]; }
          ss += shx<1>(ss); ss += shx<2>(ss); ss += shx<4>(ss); ss += shx<8>(ss);
          const float inv = __builtin_amdgcn_rsqf(fmaxf(ss, 1e-24f));
          *(LAS f32x4*)(lds + O_RF + (t * 64 + c4) * 4) = (f32x4){x[0][0], x[0][1], x[0][2], x[0][3]};
          *(LAS f32x4*)(lds + O_KDF + (t * 64 + c4) * 4) = (f32x4){x[1][0], x[1][1], x[1][2], x[1][3]};
          *(LAS f32x4*)(lds + O_KKF + (t * 64 + c4) * 4) = (f32x4){kk[0] * inv, kk[1] * inv, kk[2] * inv, kk[3] * inv};
          u32x2 vw; vw.x = pg8::cvt_pk_bf16(x[2][0], x[2][1]); vw.y = pg8::cvt_pk_bf16(x[2][2], x[2][3]); *(LAS u32x2*)(lds + O_VB + (t * LDJ + c4) * 2) = vw;
          *(LAS u32x4*)(lds + O_TW + (t * TWS + c8) * 2) = R.pw; *(LAS u32x4*)(lds + O_PA + (t * TWS + c8) * 2) = R.pa;
          if (ci + 1 < nch) load_raw(R, a, LIN, rb, Ls, tbase + tsgn * (32 + t), h, dir, c4, c8); }
        __syncthreads();
        const int n = tn * 16 + fr; float lw[4], av[4];
        { f32x4 aw = (f32x4){0.f, 0.f, 0.f, 0.f}, aa = aw;
#pragma unroll
          for (int ks = 0; ks < 4; ++ks) {
              aw = MF16(rowfrag(lds + O_TW, TWS * 2, tm * 16, ks * 32, lane), fbw[ks], aw);
              aa = MF16(rowfrag(lds + O_PA, TWS * 2, tm * 16, ks * 32, lane), fba[ks], aa); }
#pragma unroll
          for (int i = 0; i < 4; ++i) { lw[i] = -0.6065306597126334f * __builtin_amdgcn_rcpf(1.f + __builtin_amdgcn_exp2f(-1.4426950408889634f * (w0v + aw[i])));
              av[i] = __builtin_amdgcn_rcpf(1.f + __builtin_amdgcn_exp2f(-1.4426950408889634f * (a0v + aa[i]))); }
          lw[1] += lw[0]; lw[2] += lw[1]; lw[3] += lw[2];
          *((LAS float*)(lds + O_TOT) + (tm * 4 + fq) * 64 + n) = lw[3]; }
        __syncthreads();
        { const LAS float* TOT = (const LAS float*)(lds + O_TOT); const int grp = tm * 4 + fq; float off = 0.f;
#pragma unroll
          for (int g = 0; g < 7; ++g) { const float v = TOT[g * 64 + n]; off += (g < grp) ? v : 0.f; }
          float bs[4];
#pragma unroll
          for (int i = 0; i < 4; ++i) { const int t = tm * 16 + fq * 4 + i; const float G = off + lw[i], Gm = off + (i ? lw[i - 1] : 0.f);
              const float ep = __builtin_amdgcn_exp2f(1.4426950408889634f * G), em = __builtin_amdgcn_rcpf(ep), epm = __builtin_amdgcn_exp2f(1.4426950408889634f * Gm);
              const float rv = *((const LAS float*)(lds + O_RF) + t * 64 + n), kraw = *((const LAS float*)(lds + O_KDF) + t * 64 + n), kkv = *((const LAS float*)(lds + O_KKF) + t * 64 + n);
              const float kdv = kraw * (1.f + (av[i] - 1.f) * kav), bv = kkv * av[i];
              *(LAS bf16*)(lds + O_KKT + (t * LDJ + n) * 2) = tobf(kkv * epm); *(LAS bf16*)(lds + O_RT + (t * LDJ + n) * 2) = tobf(rv * ep);
              *(LAS bf16*)(lds + O_KB + (t * LDJ + n) * 2) = tobf(kdv * em); *(LAS bf16*)(lds + O_BB + (t * LDJ + n) * 2) = tobf(bv * em);
              bs[i] = rv * kdv * rkv;
              if (i == 3 && grp == 7) *((LAS float*)(lds + O_GL) + n) = ep; }
#pragma unroll
          for (int i = 0; i < 4; ++i) bs[i] += shx<1>(bs[i]);
#pragma unroll
          for (int i = 0; i < 4; ++i) bs[i] += shx<2>(bs[i]);
#pragma unroll
          for (int i = 0; i < 4; ++i) bs[i] += shx<4>(bs[i]);
#pragma unroll
          for (int i = 0; i < 4; ++i) bs[i] += shx<8>(bs[i]);
          if (fr == 0) *(LAS f32x4*)(lds + O_BP + (tn * 32 + tm * 16 + fq * 4) * 4) = (f32x4){bs[0], bs[1], bs[2], bs[3]}; }
        __syncthreads();
        if (tid < 32) { const LAS float* BP = (const LAS float*)(lds + O_BP); a.BON[((size_t)dir * NTOK + rb + tbase + tsgn * tid) * 32 + h] = (BP[tid] + BP[32 + tid]) + (BP[64 + tid] + BP[96 + tid]); }
        { const int blk = wid >> 1, tmm = wid & 1;
          const LAS unsigned char* Ab = lds + (blk < 2 ? O_KKT : O_RT); const LAS unsigned char* Bb_ = lds + ((blk & 1) ? O_BB : O_KB);
          const bf16x8 a0 = rowfrag(Ab, LDJ * 2, tmm * 16, 0, lane), a1 = rowfrag(Ab, LDJ * 2, tmm * 16, 32, lane);
#pragma unroll
          for (int tnn = 0; tnn < 2; ++tnn) { f32x4 c = (f32x4){0.f, 0.f, 0.f, 0.f};
              c = MF16(a0, rowfrag(Bb_, LDJ * 2, tnn * 16, 0, lane), c); c = MF16(a1, rowfrag(Bb_, LDJ * 2, tnn * 16, 32, lane), c);
              const int s = tnn * 16 + fr;
#pragma unroll
              for (int i = 0; i < 4; ++i) { const int t = tmm * 16 + 4 * fq + i; const bool keep = (blk < 2) ? (s < t) : (s <= t); c[i] = keep ? c[i] : 0.f; }
              if (blk == 1) {
#pragma unroll
                  for (int i = 0; i < 4; ++i) { const int t = tmm * 16 + 4 * fq + i; *((LAS float*)(lds + O_NF) + t * 33 + s) = c[i]; *(LAS bf16*)(lds + O_NB + (t * LDT + s) * 2) = tobf(c[i]); }
              } else store_ct(lds + (blk == 0 ? O_MAK : blk == 2 ? O_MRK : O_MRB), LDT * 2, tnn * 16, tmm * 16, lane, c); } }
        __syncthreads();
        if (wid == 0) {
            const int b = (lane >> 4) & 1, c = lane & 15; const LAS float* Nf = (const LAS float*)(lds + O_NF) + (16 * b) * 33 + 16 * b; float d[16];
#pragma unroll
            for (int r = 0; r < 16; ++r) d[r] = (r == c) ? 1.f : 0.f;
#pragma unroll
            for (int u = 0; u < 15; ++u) {
#pragma unroll
                for (int r = u + 1; r < 16; ++r) d[r] -= Nf[r * 33 + u] * d[u]; }
            if (lane < 32) {
#pragma unroll
                for (int r = 0; r < 16; ++r) { *(LAS bf16*)(lds + O_TM + ((16 * b + r) * LDT + 16 * b + c) * 2) = tobf(d[r]); *(LAS bf16*)(lds + O_TM + ((16 * (1 - b) + r) * LDT + 16 * b + c) * 2) = (bf16)0; } }
            asm volatile("s_waitcnt lgkmcnt(0)" ::: "memory");
            f32x4 p = (f32x4){0.f, 0.f, 0.f, 0.f};
            p = MF16(rowfrag(lds + O_NB, LDT * 2, 16, 0, lane), trfrag(lds + O_TM, LDT * 2, 0, 0, lane), p);
#pragma unroll
            for (int i = 0; i < 4; ++i) *(LAS bf16*)(lds + O_PB + ((16 + 4 * fq + i) * LDT + fr) * 2) = tobf(p[i]);
            asm volatile("s_waitcnt lgkmcnt(0)" ::: "memory");
            f32x4 x = (f32x4){0.f, 0.f, 0.f, 0.f};
            x = MF16(rowfrag(lds + O_TM, LDT * 2, 16, 0, lane), trfrag(lds + O_PB, LDT * 2, 0, 0, lane), x);
#pragma unroll
            for (int i = 0; i < 4; ++i) *(LAS bf16*)(lds + O_TM + ((16 + 4 * fq + i) * LDT + fr) * 2) = tobf(-x[i]);
        }
        { f32x4 c = (f32x4){0.f, 0.f, 0.f, 0.f};
          c = MF16(rowfrag(lds + O_KKT, LDJ * 2, tm * 16, 0, lane), trfrag(lds + O_SC, LDJ * 2, tn * 16, 0, lane), c);
          c = MF16(rowfrag(lds + O_KKT, LDJ * 2, tm * 16, 32, lane), trfrag(lds + O_SC, LDJ * 2, tn * 16, 32, lane), c);
          c = MF16(trfrag(lds + O_MAK, LDT * 2, tm * 16, 0, lane), trfrag(lds + O_VB, LDJ * 2, tn * 16, 0, lane), c);
          store_ct(lds + O_RHST, LDT * 2, tn * 16, tm * 16, lane, c); }
        __syncthreads();
        { f32x4 c = (f32x4){0.f, 0.f, 0.f, 0.f};
          c = MF16(rowfrag(lds + O_TM, LDT * 2, tm * 16, 0, lane), rowfrag(lds + O_RHST, LDT * 2, tn * 16, 0, lane), c);
          store_ct(lds + O_SAT, LDT * 2, tn * 16, tm * 16, lane, -c); }
        __syncthreads();
        { f32x4 c = (f32x4){0.f, 0.f, 0.f, 0.f};
          c = MF16(rowfrag(lds + O_RT, LDJ * 2, tm * 16, 0, lane), trfrag(lds + O_SC, LDJ * 2, tn * 16, 0, lane), c);
          c = MF16(rowfrag(lds + O_RT, LDJ * 2, tm * 16, 32, lane), trfrag(lds + O_SC, LDJ * 2, tn * 16, 32, lane), c);
          c = MF16(trfrag(lds + O_MRK, LDT * 2, tm * 16, 0, lane), trfrag(lds + O_VB, LDJ * 2, tn * 16, 0, lane), c);
          c = MF16(trfrag(lds + O_MRB, LDT * 2, tm * 16, 0, lane), rowfrag(lds + O_SAT, LDT * 2, tn * 16, 0, lane), c);
#pragma unroll
          for (int i = 0; i < 4; ++i) a.YD[((size_t)dir * NTOK + rb + tbase + tsgn * (tm * 16 + 4 * fq + i)) * 2048 + h * 64 + tn * 16 + fr] = c[i]; }
        const int ti = wid >> 1, tj0 = 2 * (wid & 1);
        { const bf16x8 sa = rowfrag(lds + O_SAT, LDT * 2, ti * 16, 0, lane), vt = trfrag(lds + O_VB, LDJ * 2, ti * 16, 0, lane);
          st0 = MF16(sa, trfrag(lds + O_BB, LDJ * 2, tj0 * 16, 0, lane), st0); st0 = MF16(vt, trfrag(lds + O_KB, LDJ * 2, tj0 * 16, 0, lane), st0);
          st1 = MF16(sa, trfrag(lds + O_BB, LDJ * 2, tj0 * 16 + 16, 0, lane), st1); st1 = MF16(vt, trfrag(lds + O_KB, LDJ * 2, tj0 * 16 + 16, 0, lane), st1);
          const LAS float* GL = (const LAS float*)(lds + O_GL); st0 = st0 * GL[tj0 * 16 + fr]; st1 = st1 * GL[tj0 * 16 + 16 + fr]; }
        __syncthreads();
        store_ct(lds + O_SC, LDJ * 2, tj0 * 16, ti * 16, lane, st0); store_ct(lds + O_SC, LDJ * 2, tj0 * 16 + 16, ti * 16, lane, st1);
    }
    __syncthreads();
}

namespace two {
constexpr int C_KKT = 0, C_RT = 5120, C_KB = 10240, C_BB = 15360, C_VB = 20480;
constexpr int C_TW = 25088, C_PA = 33792, C_RF = 42496, C_KDF = 47104, C_KKF = 51712;
constexpr int C_MAK = 25088, C_MRK = 27648, C_MRB = 30208, C_NB = 32768, C_NF = 35328, C_TM = 39552, C_PB = 42112, C_RHST = 44672, C_SAT = 49792;
constexpr int C_SC = 56320, C_GL = 65536, C_TOT = 65792, C_BP = 67840, CHS = 68352, C_MU = 2 * CHS, C_END = C_MU + 2 * 192 * 4;
static_assert(C_KKF + 4608 <= C_SC && C_SAT + 5120 <= C_SC && C_END <= RING_BYTES, "scan3 LDS map");
template <int CTRL> __device__ __forceinline__ float dppf(float x) { return __builtin_bit_cast(float, __builtin_amdgcn_update_dpp(0, __builtin_bit_cast(int, x), CTRL, 0xf, 0xf, false)); }
__device__ __forceinline__ float rsum16(float v) { v += dppf<0xB1>(v); v += dppf<0x4E>(v); v += dppf<0x141>(v); v += dppf<0x140>(v); return v; }
__device__ __forceinline__ s16x4 tr4(const LAS unsigned char* p) { return __builtin_bit_cast(s16x4, __builtin_amdgcn_ds_read_tr16_b64_v4i16((LAS v4i16_t*)p)); }
__device__ __forceinline__ float s2f(short x) { return __builtin_bit_cast(float, (unsigned)(unsigned short)x << 16); }
template <int U> __device__ __forceinline__ float bc16(float x) { return __builtin_bit_cast(float, __builtin_amdgcn_update_dpp(0, __builtin_bit_cast(int, x), 0x150 + U, 0xf, 0xf, false)); }
template <bool ST, int MODE = 0>
__device__ __forceinline__ void scan_item2(Frame& F, const P& a, const bf16* LIN, int seq, int h) {
    const int rb = seq < 4 ? seq * SEQP : 4 * SEQP, Ls = seq < 4 ? SEQP : SEQS, nch = Ls / 32;
    LAS unsigned char* lds = F.lds;
    int tid0 = F.tid; asm volatile("" : "+v"(tid0));
    for (int i = tid0; i < 2 * 9216 / 4; i += NWAVES * 64) { const int c = i / 2304, o = (i % 2304) * 4; *(LAS unsigned*)(lds + c * CHS + C_SC + o) = 0u; }
    if (tid0 < 192) { const int col = (tid0 >> 6) * 2048 + h * 64 + (tid0 & 63); *((LAS float*)(lds + C_MU) + tid0) = a.mu_prev[col]; *((LAS float*)(lds + C_MU) + 192 + tid0) = a.mu_next[col]; }
    f32x4 st0[2], st1[2]; bf16x8 fbw[2][4], fba[2][4]; float w0v[2], a0v[2], kav, rkv; f32x4 kkw; Raw R[2];
    { const int lane = tid0 & 63, wid = __builtin_amdgcn_readfirstlane(tid0 >> 6), fr = lane & 15, fq = lane >> 4, tn = wid & 3;
      const int chn = h * 64 + tn * 16 + fr; kav = a.k_a[chn]; rkv = a.r_k[chn]; kkw = *(const f32x4*)(a.k_k + h * 64 + (tid0 & 15) * 4);
#pragma unroll
      for (int c = 0; c < 2; ++c) { st0[c] = (f32x4){0.f, 0.f, 0.f, 0.f}; st1[c] = st0[c];
          const bf16* bw = a.LT + ((size_t)(0 * 2 + c) * 2048 + chn) * 128 + fq * 8; const bf16* ba = a.LT + ((size_t)(1 * 2 + c) * 2048 + chn) * 128 + fq * 8;
#pragma unroll
          for (int ks = 0; ks < 4; ++ks) { fbw[c][ks] = *(const bf16x8*)(bw + ks * 32); fba[c][ks] = *(const bf16x8*)(ba + ks * 32); }
          w0v[c] = a.w0[c * 2048 + chn]; a0v[c] = a.a0[c * 2048 + chn];
          const int t = tid0 >> 4; load_raw(R[c], a, LIN, rb, Ls, c ? (Ls - 1 - t) : t, h, c, (tid0 & 15) * 4, (tid0 & 15) * 8); } }
    __syncthreads();
    for (int ci = 0; ci < nch; ++ci) {
        int tid = tid0; asm volatile("" : "+v"(tid));
        const int lane = tid & 63, wid = __builtin_amdgcn_readfirstlane(tid >> 6), fr = lane & 15, fq = lane >> 4, tm = wid >> 2, tn = wid & 3, n = tn * 16 + fr;
        f32x4 mpv[3], mnv[3];
        { const int c4_ = (tid & 15) * 4; const LAS float* MUP_ = (const LAS float*)(lds + C_MU);
#pragma unroll
          for (int g = 0; g < 3; ++g) { mpv[g] = *(const LAS f32x4*)(MUP_ + g * 64 + c4_); mnv[g] = *(const LAS f32x4*)(MUP_ + 192 + g * 64 + c4_); } }
        if (!(MODE & 4))
#pragma unroll
        for (int c = 0; c < 2; ++c) { LAS unsigned char* cb = lds + c * CHS; const int tbase = c ? (Ls - 1 - 32 * ci) : 32 * ci, tsgn = c ? -1 : 1;
          const int t = tid >> 4, c4 = (tid & 15) * 4, c8 = (tid & 15) * 8; const LAS float* MUP = (const LAS float*)(lds + C_MU); const LAS float* MUN = MUP + 192;
          float x[3][4];
#pragma unroll
          for (int g = 0; g < 3; ++g) { const f32x4 mp = mpv[g], mn = mnv[g];
              x[g][0] = sh1(R[c].rkv[g][1].x, R[c].rkv[g][0].x, R[c].rkv[g][2].x, false, mp[0], mn[0]); x[g][1] = sh1(R[c].rkv[g][1].x, R[c].rkv[g][0].x, R[c].rkv[g][2].x, true, mp[1], mn[1]);
              x[g][2] = sh1(R[c].rkv[g][1].y, R[c].rkv[g][0].y, R[c].rkv[g][2].y, false, mp[2], mn[2]); x[g][3] = sh1(R[c].rkv[g][1].y, R[c].rkv[g][0].y, R[c].rkv[g][2].y, true, mp[3], mn[3]); }
          float kk[4], ss = 0.f;
#pragma unroll
          for (int i = 0; i < 4; ++i) { kk[i] = x[1][i] * kkw[i]; ss += kk[i] * kk[i]; }
          ss = rsum16(ss);
          const float inv = __builtin_amdgcn_rsqf(fmaxf(ss, 1e-24f));
          u32x2 w; w.x = pg8::cvt_pk_bf16(x[0][0], x[0][1]); w.y = pg8::cvt_pk_bf16(x[0][2], x[0][3]); *(LAS u32x2*)(cb + C_RF + (t * LDJ + c4) * 2) = w;
          w.x = pg8::cvt_pk_bf16(x[1][0], x[1][1]); w.y = pg8::cvt_pk_bf16(x[1][2], x[1][3]); *(LAS u32x2*)(cb + C_KDF + (t * LDJ + c4) * 2) = w;
          w.x = pg8::cvt_pk_bf16(kk[0] * inv, kk[1] * inv); w.y = pg8::cvt_pk_bf16(kk[2] * inv, kk[3] * inv); *(LAS u32x2*)(cb + C_KKF + (t * LDJ + c4) * 2) = w;
          w.x = pg8::cvt_pk_bf16(x[2][0], x[2][1]); w.y = pg8::cvt_pk_bf16(x[2][2], x[2][3]); *(LAS u32x2*)(cb + C_VB + (t * LDJ + c4) * 2) = w;
          *(LAS u32x4*)(cb + C_TW + (t * TWS + c8) * 2) = R[c].pw; *(LAS u32x4*)(cb + C_PA + (t * TWS + c8) * 2) = R[c].pa;
          if (!(MODE & 1) && ci + 1 < nch) load_raw(R[c], a, LIN, rb, Ls, tbase + tsgn * (32 + t), h, c, c4, c8); }
        __syncthreads();
        float lw[2][4] = {{0.f, 0.f, 0.f, 0.f}, {0.f, 0.f, 0.f, 0.f}}, av[2][4] = {{0.f, 0.f, 0.f, 0.f}, {0.f, 0.f, 0.f, 0.f}};
        if (!(MODE & 8))
        { bf16x8 f2[2][8];
#pragma unroll
        for (int c = 0; c < 2; ++c) { LAS unsigned char* cb = lds + c * CHS;
#pragma unroll
          for (int ks = 0; ks < 4; ++ks) { f2[c][ks] = rowfrag(cb + C_TW, TWS * 2, tm * 16, ks * 32, lane); f2[c][4 + ks] = rowfrag(cb + C_PA, TWS * 2, tm * 16, ks * 32, lane); } }
        __builtin_amdgcn_sched_barrier(0);
#pragma unroll
        for (int c = 0; c < 2; ++c) { LAS unsigned char* cb = lds + c * CHS; f32x4 aw = (f32x4){0.f, 0.f, 0.f, 0.f}, aa = aw;
#pragma unroll
          for (int ks = 0; ks < 4; ++ks) { aw = MF16(f2[c][ks], fbw[c][ks], aw); aa = MF16(f2[c][4 + ks], fba[c][ks], aa); }
#pragma unroll
          for (int i = 0; i < 4; ++i) { lw[c][i] = -0.6065306597126334f * __builtin_amdgcn_rcpf(1.f + __builtin_amdgcn_exp2f(-1.4426950408889634f * (w0v[c] + aw[i])));
              av[c][i] = __builtin_amdgcn_rcpf(1.f + __builtin_amdgcn_exp2f(-1.4426950408889634f * (a0v[c] + aa[i]))); }
          lw[c][1] += lw[c][0]; lw[c][2] += lw[c][1]; lw[c][3] += lw[c][2];
          *((LAS float*)(cb + C_TOT) + (tm * 4 + fq) * 64 + n) = lw[c][3]; } }
        __syncthreads();
        if (!(MODE & 16))
        { float tot[2][7]; s16x4 rr2[2], kr2[2], kkr2[2];
#pragma unroll
        for (int c = 0; c < 2; ++c) { LAS unsigned char* cb = lds + c * CHS; const LAS float* TOT = (const LAS float*)(cb + C_TOT);
#pragma unroll
          for (int g = 0; g < 7; ++g) tot[c][g] = TOT[g * 64 + n];
          const LAS unsigned char* trp = cb + ((tm * 16 + 4 * fq + (fr >> 2)) * LDJ + tn * 16 + (fr & 3) * 4) * 2;
          rr2[c] = tr4(trp + C_RF); kr2[c] = tr4(trp + C_KDF); kkr2[c] = tr4(trp + C_KKF); }
        __builtin_amdgcn_sched_barrier(0);
#pragma unroll
        for (int c = 0; c < 2; ++c) { LAS unsigned char* cb = lds + c * CHS; const int grp = tm * 4 + fq; float off = 0.f;
#pragma unroll
          for (int g = 0; g < 7; ++g) off += (g < grp) ? tot[c][g] : 0.f;
          const s16x4 rr = rr2[c], kr = kr2[c], kkr = kkr2[c];
          float bs[4]; f32x4 okk, ort, okb, obb; float epm = __builtin_amdgcn_exp2f(1.4426950408889634f * off);
#pragma unroll
          for (int i = 0; i < 4; ++i) { const float G = off + lw[c][i];
              const float ep = __builtin_amdgcn_exp2f(1.4426950408889634f * G), em = __builtin_amdgcn_rcpf(ep);
              const float rv = s2f(rr[i]), kraw = s2f(kr[i]), kkv = s2f(kkr[i]);
              const float kdv = kraw * (1.f + (av[c][i] - 1.f) * kav), bv = kkv * av[c][i];
              okk[i] = kkv * epm; ort[i] = rv * ep; okb[i] = kdv * em; obb[i] = bv * em;
              bs[i] = rv * kdv * rkv; epm = ep;
              if (i == 3 && grp == 7) *((LAS float*)(cb + C_GL) + n) = ep; }
          store_ct(cb + C_KKT, LDT * 2, tn * 16, tm * 16, lane, okk); store_ct(cb + C_RT, LDT * 2, tn * 16, tm * 16, lane, ort);
          store_ct(cb + C_KB, LDT * 2, tn * 16, tm * 16, lane, okb); store_ct(cb + C_BB, LDT * 2, tn * 16, tm * 16, lane, obb);
#pragma unroll
          for (int i = 0; i < 4; ++i) bs[i] = rsum16(bs[i]);
          if (fr == 0) *(LAS f32x4*)(cb + C_BP + (tn * 32 + tm * 16 + fq * 4) * 4) = (f32x4){bs[0], bs[1], bs[2], bs[3]}; } }
        __syncthreads();
        if (!(MODE & 32)) {
        if (tid < 64) { const int c = tid >> 5, t = tid & 31; const LAS float* BP = (const LAS float*)(lds + c * CHS + C_BP); const int tok = c ? (Ls - 1 - 32 * ci - t) : (32 * ci + t);
            if (ST) a.BON[((size_t)c * NTOK + rb + tok) * 32 + h] = (BP[t] + BP[32 + t]) + (BP[64 + t] + BP[96 + t]); }
        if (tid >= 64 && tid < 64 + 160) { const int i = tid - 64, c = i / 80, o = (i % 80) * 16; *(LAS u32x4*)(lds + c * CHS + C_PB + o) = (u32x4){0u, 0u, 0u, 0u}; }
        if (tid >= 256 && tid < 384) { const int i = tid - 256, c = i >> 6, r = (i & 63) >> 1, hf = i & 1;
            *(LAS u32x4*)(lds + c * CHS + C_TM + (r * LDT + (r < 16 ? 16 : 0)) * 2 + hf * 16) = (u32x4){0u, 0u, 0u, 0u}; }
        bf16x8 f4a[2][2], f4b[2][2][2];
#pragma unroll
        for (int c = 0; c < 2; ++c) { LAS unsigned char* cb = lds + c * CHS; const int blk = wid >> 1, tmm = wid & 1;
          const LAS unsigned char* Ab = cb + (blk < 2 ? C_KKT : C_RT); const LAS unsigned char* Bb_ = cb + ((blk & 1) ? C_BB : C_KB);
          f4a[c][0] = trfrag(Ab, LDT * 2, tmm * 16, 0, lane); f4a[c][1] = trfrag(Ab, LDT * 2, tmm * 16, 32, lane);
#pragma unroll
          for (int tnn = 0; tnn < 2; ++tnn) { f4b[c][tnn][0] = trfrag(Bb_, LDT * 2, tnn * 16, 0, lane); f4b[c][tnn][1] = trfrag(Bb_, LDT * 2, tnn * 16, 32, lane); } }
        __builtin_amdgcn_sched_barrier(0);
#pragma unroll
        for (int c = 0; c < 2; ++c) { LAS unsigned char* cb = lds + c * CHS; const int blk = wid >> 1, tmm = wid & 1;
          const bf16x8 a0 = f4a[c][0], a1 = f4a[c][1]; const int lim = tmm * 16 + 4 * fq + (blk >= 2 ? 1 : 0);
#pragma unroll
          for (int tnn = 0; tnn < 2; ++tnn) { f32x4 cc = (f32x4){0.f, 0.f, 0.f, 0.f};
              cc = MF16(a0, f4b[c][tnn][0], cc); cc = MF16(a1, f4b[c][tnn][1], cc);
              const int s = tnn * 16 + fr;
#pragma unroll
              for (int i = 0; i < 4; ++i) cc[i] = (s < lim + i) ? cc[i] : 0.f;
              if (blk == 1) {
#pragma unroll
                  for (int i = 0; i < 4; ++i) { const int t = tmm * 16 + 4 * fq + i; *((LAS float*)(cb + C_NF) + t * 33 + s) = cc[i]; *(LAS bf16*)(cb + C_NB + (t * LDT + s) * 2) = tobf(cc[i]); }
              } else store_ct(cb + (blk == 0 ? C_MAK : blk == 2 ? C_MRK : C_MRB), LDT * 2, tnn * 16, tmm * 16, lane, cc); } }
        }
        __syncthreads();
        if (wid < 2 && !(MODE & 2)) { LAS unsigned char* cb = lds + wid * CHS;
#define FD(acc, n, x, U) asm volatile("v_fmac_f32_dpp %0, %1, %2 row_newbcast:" #U " row_mask:0xf bank_mask:0xf" : "+v"(acc) : "v"(n), "v"(x))
#define FD0(acc, n, x, U) asm volatile("s_nop 1\n\tv_fmac_f32_dpp %0, %1, %2 row_newbcast:" #U " row_mask:0xf bank_mask:0xf" : "+v"(acc) : "v"(n), "v"(x))
            const int b = (lane >> 4) & 1, c = lane & 15; const LAS float* Nf = (const LAS float*)(cb + C_NF) + (16 * b) * 33 + 16 * b + c; float d[16], nd[16];
            float nr[16];
#pragma unroll
            for (int r = 1; r < 16; ++r) nr[r] = Nf[r * 33];
            asm volatile("" :: "v"(nr[1]), "v"(nr[2]), "v"(nr[3]), "v"(nr[4]), "v"(nr[5]), "v"(nr[6]), "v"(nr[7]), "v"(nr[8]), "v"(nr[9]), "v"(nr[10]), "v"(nr[11]), "v"(nr[12]), "v"(nr[13]), "v"(nr[14]), "v"(nr[15]));
            d[0] = (c == 0) ? 1.f : 0.f; nd[0] = -d[0];
            { const float n_ = nr[1]; float a0 = (c == 1) ? 1.f : 0.f, a1 = 0.f; float s_ = a0 + a1; FD0(s_, n_, nd[0], 0); d[1] = s_; nd[1] = -s_; }
            { const float n_ = nr[2]; float a0 = (c == 2) ? 1.f : 0.f, a1 = 0.f; FD0(a0, n_, nd[0], 0); float s_ = a0 + a1; FD(s_, n_, nd[1], 1); d[2] = s_; nd[2] = -s_; }
            { const float n_ = nr[3]; float a0 = (c == 3) ? 1.f : 0.f, a1 = 0.f; FD0(a0, n_, nd[0], 0); FD(a1, n_, nd[1], 1); float s_ = a0 + a1; FD(s_, n_, nd[2], 2); d[3] = s_; nd[3] = -s_; }
            { const float n_ = nr[4]; float a0 = (c == 4) ? 1.f : 0.f, a1 = 0.f; FD0(a0, n_, nd[0], 0); FD(a1, n_, nd[1], 1); FD(a0, n_, nd[2], 2); float s_ = a0 + a1; FD(s_, n_, nd[3], 3); d[4] = s_; nd[4] = -s_; }
            { const float n_ = nr[5]; float a0 = (c == 5) ? 1.f : 0.f, a1 = 0.f; FD0(a0, n_, nd[0], 0); FD(a1, n_, nd[1], 1); FD(a0, n_, nd[2], 2); FD(a1, n_, nd[3], 3); float s_ = a0 + a1; FD(s_, n_, nd[4], 4); d[5] = s_; nd[5] = -s_; }
            { const float n_ = nr[6]; float a0 = (c == 6) ? 1.f : 0.f, a1 = 0.f; FD0(a0, n_, nd[0], 0); FD(a1, n_, nd[1], 1); FD(a0, n_, nd[2], 2); FD(a1, n_, nd[3], 3); FD(a0, n_, nd[4], 4); float s_ = a0 + a1; FD(s_, n_, nd[5], 5); d[6] = s_; nd[6] = -s_; }
            { const float n_ = nr[7]; float a0 = (c == 7) ? 1.f : 0.f, a1 = 0.f; FD0(a0, n_, nd[0], 0); FD(a1, n_, nd[1], 1); FD(a0, n_, nd[2], 2); FD(a1, n_, nd[3], 3); FD(a0, n_, nd[4], 4); FD(a1, n_, nd[5], 5); float s_ = a0 + a1; FD(s_, n_, nd[6], 6); d[7] = s_; nd[7] = -s_; }
            { const float n_ = nr[8]; float a0 = (c == 8) ? 1.f : 0.f, a1 = 0.f; FD0(a0, n_, nd[0], 0); FD(a1, n_, nd[1], 1); FD(a0, n_, nd[2], 2); FD(a1, n_, nd[3], 3); FD(a0, n_, nd[4], 4); FD(a1, n_, nd[5], 5); FD(a0, n_, nd[6], 6); float s_ = a0 + a1; FD(s_, n_, nd[7], 7); d[8] = s_; nd[8] = -s_; }
            { const float n_ = nr[9]; float a0 = (c == 9) ? 1.f : 0.f, a1 = 0.f; FD0(a0, n_, nd[0], 0); FD(a1, n_, nd[1], 1); FD(a0, n_, nd[2], 2); FD(a1, n_, nd[3], 3); FD(a0, n_, nd[4], 4); FD(a1, n_, nd[5], 5); FD(a0, n_, nd[6], 6); FD(a1, n_, nd[7], 7); float s_ = a0 + a1; FD(s_, n_, nd[8], 8); d[9] = s_; nd[9] = -s_; }
            { const float n_ = nr[10]; float a0 = (c == 10) ? 1.f : 0.f, a1 = 0.f; FD0(a0, n_, nd[0], 0); FD(a1, n_, nd[1], 1); FD(a0, n_, nd[2], 2); FD(a1, n_, nd[3], 3); FD(a0, n_, nd[4], 4); FD(a1, n_, nd[5], 5); FD(a0, n_, nd[6], 6); FD(a1, n_, nd[7], 7); FD(a0, n_, nd[8], 8); float s_ = a0 + a1; FD(s_, n_, nd[9], 9); d[10] = s_; nd[10] = -s_; }
            { const float n_ = nr[11]; float a0 = (c == 11) ? 1.f : 0.f, a1 = 0.f; FD0(a0, n_, nd[0], 0); FD(a1, n_, nd[1], 1); FD(a0, n_, nd[2], 2); FD(a1, n_, nd[3], 3); FD(a0, n_, nd[4], 4); FD(a1, n_, nd[5], 5); FD(a0, n_, nd[6], 6); FD(a1, n_, nd[7], 7); FD(a0, n_, nd[8], 8); FD(a1, n_, nd[9], 9); float s_ = a0 + a1; FD(s_, n_, nd[10], 10); d[11] = s_; nd[11] = -s_; }
            { const float n_ = nr[12]; float a0 = (c == 12) ? 1.f : 0.f, a1 = 0.f; FD0(a0, n_, nd[0], 0); FD(a1, n_, nd[1], 1); FD(a0, n_, nd[2], 2); FD(a1, n_, nd[3], 3); FD(a0, n_, nd[4], 4); FD(a1, n_, nd[5], 5); FD(a0, n_, nd[6], 6); FD(a1, n_, nd[7], 7); FD(a0, n_, nd[8], 8); FD(a1, n_, nd[9], 9); FD(a0, n_, nd[10], 10); float s_ = a0 + a1; FD(s_, n_, nd[11], 11); d[12] = s_; nd[12] = -s_; }
            { const float n_ = nr[13]; float a0 = (c == 13) ? 1.f : 0.f, a1 = 0.f; FD0(a0, n_, nd[0], 0); FD(a1, n_, nd[1], 1); FD(a0, n_, nd[2], 2); FD(a1, n_, nd[3], 3); FD(a0, n_, nd[4], 4); FD(a1, n_, nd[5], 5); FD(a0, n_, nd[6], 6); FD(a1, n_, nd[7], 7); FD(a0, n_, nd[8], 8); FD(a1, n_, nd[9], 9); FD(a0, n_, nd[10], 10); FD(a1, n_, nd[11], 11); float s_ = a0 + a1; FD(s_, n_, nd[12], 12); d[13] = s_; nd[13] = -s_; }
            { const float n_ = nr[14]; float a0 = (c == 14) ? 1.f : 0.f, a1 = 0.f; FD0(a0, n_, nd[0], 0); FD(a1, n_, nd[1], 1); FD(a0, n_, nd[2], 2); FD(a1, n_, nd[3], 3); FD(a0, n_, nd[4], 4); FD(a1, n_, nd[5], 5); FD(a0, n_, nd[6], 6); FD(a1, n_, nd[7], 7); FD(a0, n_, nd[8], 8); FD(a1, n_, nd[9], 9); FD(a0, n_, nd[10], 10); FD(a1, n_, nd[11], 11); FD(a0, n_, nd[12], 12); float s_ = a0 + a1; FD(s_, n_, nd[13], 13); d[14] = s_; nd[14] = -s_; }
            { const float n_ = nr[15]; float a0 = (c == 15) ? 1.f : 0.f, a1 = 0.f; FD0(a0, n_, nd[0], 0); FD(a1, n_, nd[1], 1); FD(a0, n_, nd[2], 2); FD(a1, n_, nd[3], 3); FD(a0, n_, nd[4], 4); FD(a1, n_, nd[5], 5); FD(a0, n_, nd[6], 6); FD(a1, n_, nd[7], 7); FD(a0, n_, nd[8], 8); FD(a1, n_, nd[9], 9); FD(a0, n_, nd[10], 10); FD(a1, n_, nd[11], 11); FD(a0, n_, nd[12], 12); FD(a1, n_, nd[13], 13); float s_ = a0 + a1; FD(s_, n_, nd[14], 14); d[15] = s_; nd[15] = -s_; }
#undef FD
#undef FD0
            if (lane < 32) {
#pragma unroll
                for (int r = 0; r < 16; ++r) *(LAS bf16*)(cb + C_TM + ((16 * b + r) * LDT + 16 * b + c) * 2) = tobf(d[r]); }
            asm volatile("s_waitcnt lgkmcnt(0)" ::: "memory");
            f32x4 p = (f32x4){0.f, 0.f, 0.f, 0.f};
            p = MF16(rowfrag(cb + C_NB, LDT * 2, 16, 0, lane), trfrag(cb + C_TM, LDT * 2, 0, 0, lane), p);
#pragma unroll
            for (int i = 0; i < 4; ++i) *(LAS bf16*)(cb + C_PB + ((16 + 4 * fq + i) * LDT + fr) * 2) = tobf(p[i]);
            asm volatile("s_waitcnt lgkmcnt(0)" ::: "memory");
            f32x4 x = (f32x4){0.f, 0.f, 0.f, 0.f};
            x = MF16(rowfrag(cb + C_TM, LDT * 2, 16, 0, lane), trfrag(cb + C_PB, LDT * 2, 0, 0, lane), x);
#pragma unroll
            for (int i = 0; i < 4; ++i) *(LAS bf16*)(cb + C_TM + ((16 + 4 * fq + i) * LDT + fr) * 2) = tobf(-x[i]);
        }
        if (!(MODE & 64))
        { bf16x8 f7[2][6];
#pragma unroll
          for (int c = 0; c < 2; ++c) { LAS unsigned char* cb = lds + c * CHS;
            f7[c][0] = trfrag(cb + C_KKT, LDT * 2, tm * 16, 0, lane); f7[c][1] = trfrag(cb + C_SC, LDJ * 2, tn * 16, 0, lane); f7[c][2] = trfrag(cb + C_KKT, LDT * 2, tm * 16, 32, lane); f7[c][3] = trfrag(cb + C_SC, LDJ * 2, tn * 16, 32, lane);
            f7[c][4] = trfrag(cb + C_MAK, LDT * 2, tm * 16, 0, lane); f7[c][5] = trfrag(cb + C_VB, LDJ * 2, tn * 16, 0, lane); }
          __builtin_amdgcn_sched_barrier(0);
#pragma unroll
          for (int c = 0; c < 2; ++c) { LAS unsigned char* cb = lds + c * CHS; f32x4 cc = (f32x4){0.f, 0.f, 0.f, 0.f};
            cc = MF16(f7[c][0], f7[c][1], cc); cc = MF16(f7[c][2], f7[c][3], cc); cc = MF16(f7[c][4], f7[c][5], cc);
            store_ct(cb + C_RHST, LDT * 2, tn * 16, tm * 16, lane, cc); } }
        __syncthreads();
        if (!(MODE & 128))
        { bf16x8 f8[2][2];
#pragma unroll
          for (int c = 0; c < 2; ++c) { LAS unsigned char* cb = lds + c * CHS; f8[c][0] = rowfrag(cb + C_TM, LDT * 2, tm * 16, 0, lane); f8[c][1] = rowfrag(cb + C_RHST, LDT * 2, tn * 16, 0, lane); }
          __builtin_amdgcn_sched_barrier(0);
#pragma unroll
          for (int c = 0; c < 2; ++c) { LAS unsigned char* cb = lds + c * CHS; f32x4 cc = (f32x4){0.f, 0.f, 0.f, 0.f};
            cc = MF16(f8[c][0], f8[c][1], cc);
            store_ct(cb + C_SAT, LDT * 2, tn * 16, tm * 16, lane, -cc); } }
        __syncthreads();
        const int ti = wid >> 1, tj0 = 2 * (wid & 1);
        if (!(MODE & 256))
#pragma unroll
        for (int c = 0; c < 2; ++c) { LAS unsigned char* cb = lds + c * CHS; const int tbase = c ? (Ls - 1 - 32 * ci) : 32 * ci, tsgn = c ? -1 : 1; f32x4 cc = (f32x4){0.f, 0.f, 0.f, 0.f};
          bf16x8 f9[14]; const LAS float* GL = (const LAS float*)(cb + C_GL);
          f9[0] = trfrag(cb + C_RT, LDT * 2, tm * 16, 0, lane); f9[1] = trfrag(cb + C_SC, LDJ * 2, tn * 16, 0, lane); f9[2] = trfrag(cb + C_RT, LDT * 2, tm * 16, 32, lane); f9[3] = trfrag(cb + C_SC, LDJ * 2, tn * 16, 32, lane);
          f9[4] = trfrag(cb + C_MRK, LDT * 2, tm * 16, 0, lane); f9[5] = trfrag(cb + C_VB, LDJ * 2, tn * 16, 0, lane); f9[6] = trfrag(cb + C_MRB, LDT * 2, tm * 16, 0, lane); f9[7] = rowfrag(cb + C_SAT, LDT * 2, tn * 16, 0, lane);
          f9[8] = rowfrag(cb + C_SAT, LDT * 2, ti * 16, 0, lane); f9[9] = trfrag(cb + C_VB, LDJ * 2, ti * 16, 0, lane);
          f9[10] = rowfrag(cb + C_BB, LDT * 2, tj0 * 16, 0, lane); f9[11] = rowfrag(cb + C_KB, LDT * 2, tj0 * 16, 0, lane); f9[12] = rowfrag(cb + C_BB, LDT * 2, tj0 * 16 + 16, 0, lane); f9[13] = rowfrag(cb + C_KB, LDT * 2, tj0 * 16 + 16, 0, lane);
          const float gl0 = GL[tj0 * 16 + fr], gl1 = GL[tj0 * 16 + 16 + fr];
          __builtin_amdgcn_sched_barrier(0);
          cc = MF16(f9[0], f9[1], cc); cc = MF16(f9[2], f9[3], cc); cc = MF16(f9[4], f9[5], cc); cc = MF16(f9[6], f9[7], cc);
#pragma unroll
          for (int i = 0; i < 4; ++i) { if (ST) ((bf16*)a.YD)[((size_t)c * NTOK + rb + tbase + tsgn * (tm * 16 + 4 * fq + i)) * 2048 + h * 64 + tn * 16 + fr] = tobf(cc[i]); else asm volatile("" :: "v"(cc[i])); }
          st0[c] = MF16(f9[8], f9[10], st0[c]); st0[c] = MF16(f9[9], f9[11], st0[c]);
          st1[c] = MF16(f9[8], f9[12], st1[c]); st1[c] = MF16(f9[9], f9[13], st1[c]);
          st0[c] = st0[c] * gl0; st1[c] = st1[c] * gl1; __builtin_amdgcn_sched_barrier(0); }
        __syncthreads();
#pragma unroll
        for (int c = 0; c < 2; ++c) { LAS unsigned char* cb = lds + c * CHS; store_ct(cb + C_SC, LDJ * 2, tj0 * 16, ti * 16, lane, st0[c]); store_ct(cb + C_SC, LDJ * 2, tj0 * 16 + 16, ti * 16, lane, st1[c]); }
    }
    __syncthreads();
}
}
#undef MF16
}
constexpr int NPHASE = 9;
struct Args { const float* in[24]; float* out; unsigned char* ws; int ph_lo, ph_hi; };
__global__ void __launch_bounds__(NWAVES * 64, 2) fwd_kernel(Args args) {
    extern __shared__ __attribute__((aligned(16))) unsigned char lds[];
    Frame F;
    F.lds = (LAS unsigned char*)lds;
    F.MISC = (volatile LAS unsigned*)(F.lds + MISC_OFF);
    F.tid = threadIdx.x; F.lane = F.tid & 63; F.wave = __builtin_amdgcn_readfirstlane(F.tid >> 6);
    F.G = gridDim.x; { const int bx = blockIdx.x; F.vcu = (F.G % 8 == 0) ? (bx % 8) * (F.G / 8) + bx / 8 : bx; }
    unsigned char* ws = args.ws;
    F.ctl = (gu32*)(ws + WS_CTL);
    for (int u = F.tid; u < (LDS_BYTES - MISC_OFF) / 4; u += NWAVES * 64) ((LAS unsigned*)(F.lds + MISC_OFF))[u] = 0u;
    __syncthreads();
    const int lo = args.ph_lo, hi = args.ph_hi;
    XcdBarrier bar; bar.bar = (unsigned*)(F.ctl + CW_BAR); bar.x = 0; bar.st = nullptr;
    if (hi - lo > 1) bar = xcd_barrier_post((unsigned*)(F.ctl + CW_BAR), F.MISC + 8);
#ifdef ONLYPH
#define IN(k) ((k) == ONLYPH && lo <= (k) && (k) < hi)
#else
#define IN(k) (lo <= (k) && (k) < hi)
#endif
#define SEAM(k) do { if (IN(k) && IN((k) + 1)) xcd_barrier(bar); } while (0)
    const float *x_prompt = args.in[0], *x_sample = args.in[1], *norm_g = args.in[2], *w_in = args.in[3], *mu_prev = args.in[4], *mu_next = args.in[5];
    const float *lam_q1 = args.in[6], *lam_k1 = args.in[7], *lam_q2 = args.in[8], *lam_k2 = args.in[9], *subln_g = args.in[10];
    const float *w0 = args.in[11], *w_lora = args.in[12], *a0 = args.in[13], *a_lora = args.in[14], *k_k = args.in[15], *k_a = args.in[16], *r_k = args.in[17];
    const float *lnx_g = args.in[18], *lnx_b = args.in[19], *w_oA = args.in[20], *w_oB = args.in[21], *w_out = args.in[22], *final_g = args.in[23];
    float* ROPE = (float*)(ws + WS_ROPE); bf16* LT = (bf16*)(ws + WS_LORA); float* BON = (float*)(ws + WS_BONUS); float* PART = (float*)(ws + WS_PART);
    bf16 *WOA = (bf16*)(ws + WS_WOA), *WOB = (bf16*)(ws + WS_WOB), *WOUT = (bf16*)(ws + WS_WOUT), *WIN = (bf16*)(ws + WS_WIN), *Hb = (bf16*)(ws + WS_H);
    bf16 *Qb = (bf16*)(ws + WS_Q), *Kb = (bf16*)(ws + WS_K), *Vb = (bf16*)(ws + WS_V), *SL = (bf16*)(ws + WS_SLAB), *YBb = (bf16*)(ws + WS_YB), *Mb = (bf16*)(ws + WS_M), *LIN = (bf16*)(ws + WS_LIN);
    bf16* Gb = (bf16*)args.out;
    float* YD = args.out;
    const int gw = F.vcu * NWAVES + F.wave, NGW = F.G * NWAVES;

    if (IN(0)) {
        LAS float* scr = (LAS float*)(F.lds + RING_OFF + F.wave * 16384);
        constexpr int I_IN = (DM / 64) * (NIN / 32), I_OA = (WA / 64) * (DM / 32), I_OUT = (DM / 64) * (DM / 32), I_L = (128 / 64) * (WA / 32);
        constexpr int NITEMS = I_IN + 2 * I_OA + I_OUT + 4 * I_L;
        for (int it = gw; it < NITEMS; it += NGW) {
            int r = it;
            if (r < I_IN) { p0_transpose_item(w_in, DM, NIN, WIN, scr, r, F.lane, true); continue; } r -= I_IN;
            if (r < I_OA) { p0_transpose_item(w_oA, WA, DM, WOA, scr, r, F.lane, false); continue; } r -= I_OA;
            if (r < I_OA) { p0_transpose_item(w_oB, WA, DM, WOB, scr, r, F.lane, false); continue; } r -= I_OA;
            if (r < I_OUT) { p0_transpose_item(w_out, DM, DM, WOUT, scr, r, F.lane, false); continue; } r -= I_OUT;
            const int which = r / I_L; r -= which * I_L;
            p0_transpose_item((which < 2 ? w_lora : a_lora) + (size_t)(which & 1) * 128 * WA, 128, WA, LT + (size_t)which * WA * 128, scr, r, F.lane, false);
        }
        for (int m = gw; m < NTOK; m += NGW) rms_row_to_bf16(m < 4 * SEQP ? x_prompt + (size_t)m * DM : x_sample + (size_t)(m - 4 * SEQP) * DM, norm_g, Hb + (size_t)m * DM, F.lane);
        for (int e = blockIdx.x * (NWAVES * 64) + F.tid; e < SEQS * 32; e += F.G * NWAVES * 64) { const int pos = e >> 5, i = e & 31;
            const float inv = 1.0f / powf(10000.f, (float)(2 * i) / 64.f); const float ang = (float)pos * inv; double sn, cs; sincos((double)ang, &sn, &cs);
            ROPE[2 * e] = (float)cs; ROPE[2 * e + 1] = (float)sn; }
    }
    SEAM(0);
    if (IN(1)) {
        pg8::Gemm g{Hb, WIN, NTOK, N_A, DM}; pg8::StaticOrder S; S.init(NTOK, N_A, F.G, (int)blockIdx.x);
        pg8::EpiInA E{Qb, Kb, Vb, SL, ROPE};
        pg8::gemm_phase<pg8::EpiInA, pg8::StaticOrder, true, true>(F.lds + RING_OFF, g, S, E);
    }
    SEAM(1);
    if (IN(2)) { const scan1::P sp{SL, mu_prev, mu_next, w0, a0, k_k, k_a, r_k, LT, YD, BON}; scan2::lora_inputs(F, sp, LIN); }
    SEAM(2);
    if (IN(3)) {
        { const float a = wave_sum(lam_q1[F.lane] * lam_k1[F.lane]), b = wave_sum(lam_q2[F.lane] * lam_k2[F.lane]); if (F.tid == 0) F.MISC[1] = __builtin_bit_cast(unsigned, __expf(a) - __expf(b) + 0.2f); }
        __syncthreads();
        const scan1::P sp{SL, mu_prev, mu_next, w0, a0, k_k, k_a, r_k, LT, YD, BON};
        constexpr int Q_SS = 4, Q_SP = 16, Q_AS = 256, Q_AP = 256, Q_ALL = Q_SS + Q_SP + Q_AS + Q_AP;
        const int myx = (int)(xb_xcc_id() & 7u);
        for (int kq = 0; kq < 8; ++kq) { const int qx = (myx + kq) & 7;
            for (;;) {
                __syncthreads();
                if (F.tid == 0) { F.MISC[0] = __hip_atomic_fetch_add(F.ctl + CW_QUEUE + 64 * qx, 1u, RLX_AGENT); F.MISC[2] = __hip_atomic_load(F.ctl + CW_POS + 64 * qx, RLX_AGENT); }
                __syncthreads();
                int it = (int)F.MISC[0];
                if (it >= Q_ALL) break;
                if (it < Q_SS) { scan2::two::scan_item2<true>(F, sp, LIN, 4, 4 * qx + it); continue; } it -= Q_SS;
                if (it < Q_SP) { scan2::two::scan_item2<true>(F, sp, LIN, it >> 2, 4 * qx + (it & 3)); continue; } it -= Q_SP;
                const unsigned pos = F.MISC[2];
                if (it < Q_AS) { const int hh = 2 * qx + (it >> 7); const unsigned hk = 1u + 64u + (unsigned)hh;
                    att::attn_unit(F.lds, Qb, Kb, Vb, Qb, 4 * SEQP, SEQS, hh, (it & 127) * 128, (const LAS float*)(F.lds + MISC_OFF + 4), subln_g); continue; } it -= Q_AS;
                { const int seq = it >> 6, r = it & 63, hh = 2 * qx + (r >> 5); const unsigned hk = 1u + 16u * (unsigned)seq + (unsigned)hh;
                  att::attn_unit(F.lds, Qb, Kb, Vb, Qb, seq * SEQP, SEQP, hh, (r & 31) * 128, (const LAS float*)(F.lds + MISC_OFF + 4), subln_g); }
            }
        }
    }
    SEAM(3);
    if (IN(4)) { const scan1::P sp{SL, mu_prev, mu_next, w0, a0, k_k, k_a, r_k, LT, YD, BON}; scan1::finalize(F, sp, lnx_g, lnx_b, YBb); }
    SEAM(4);
    if (IN(5)) {
        { pg8::Gemm g{Hb, WIN + (size_t)N_A * DM, NTOK, 4096, DM}; pg8::StaticOrder S; S.init(NTOK, 4096, F.G, (int)blockIdx.x);
          pg8::EpiZ E{Qb, YBb}; pg8::gemm_phase<pg8::EpiZ, pg8::StaticOrder, true, true>(F.lds + RING_OFF, g, S, E); }
        __syncthreads();
        { pg8::Gemm g{Hb, WIN + (size_t)(N_A + 4096) * DM, NTOK, 8192, DM}; pg8::StaticOrder S; S.init(NTOK, 8192, F.G, (int)blockIdx.x);
          pg8::EpiG E{Gb}; pg8::gemm_phase<pg8::EpiG, pg8::StaticOrder, true, true>(F.lds + RING_OFF, g, S, E); }
    }
    SEAM(5);
    if (IN(6)) {
        pg8::StaticOrder S; S.init(NTOK, DM, F.G, (int)blockIdx.x);
        { pg8::Gemm g{Qb, WOA, NTOK, DM, WA}; pg8::EpiM<false> E{Mb, Gb}; pg8::gemm_phase<pg8::EpiM<false>, pg8::StaticOrder, true, true>(F.lds + RING_OFF, g, S, E); }
        __syncthreads();
        { pg8::Gemm g{YBb, WOB, NTOK, DM, WA}; pg8::EpiM<true> E{Mb, Gb}; pg8::gemm_phase<pg8::EpiM<true>, pg8::StaticOrder, true, true>(F.lds + RING_OFF, g, S, E); }
    }
    SEAM(6);
    if (IN(7)) {
        pg8::Gemm g{Mb, WOUT, NTOK, DM, DM}; pg8::StaticOrder S; S.init(NTOK, DM, F.G, (int)blockIdx.x);
        pg8::EpiOut E{x_prompt, x_sample, Qb, PART};
        pg8::gemm_phase<pg8::EpiOut, pg8::StaticOrder, true, true>(F.lds + RING_OFF, g, S, E);
    }
    SEAM(7);
    if (IN(8)) {
        const bool poison = (hi - lo > 1) && (__hip_atomic_load((gu32*)((unsigned*)(F.ctl + CW_BAR) + XB_TMO), RLX_AGENT) != 0u);
        for (int row = gw; row < NTOK; row += NGW) {
            const float ss = wave_sum(PART[(size_t)row * 64 + F.lane]); float rs = 1.f / sqrtf(ss * (1.f / 4096.f) + 1e-6f);
            if (poison) rs = __builtin_nanf("");
            const GAS u32x4* pr = (const GAS u32x4*)(Qb + (size_t)row * DM) + F.lane; GAS f32x4* o = (GAS f32x4*)(args.out + (size_t)row * DM) + 2 * F.lane; const GAS f32x4* gg = (const GAS f32x4*)final_g + 2 * F.lane;
#pragma unroll
            for (int j = 0; j < 8; ++j) { const u32x4 v = pr[64 * j]; const f32x4 g0 = gg[128 * j], g1 = gg[128 * j + 1];
                o[128 * j] = (f32x4){pg8::bflo(v.x), pg8::bfhi(v.x), pg8::bflo(v.y), pg8::bfhi(v.y)} * rs * g0; o[128 * j + 1] = (f32x4){pg8::bflo(v.z), pg8::bfhi(v.z), pg8::bflo(v.w), pg8::bfhi(v.w)} * rs * g1; }
        }
    }
#undef IN
#undef SEAM
}

extern "C" void kernel_launch(void* const* d_in, const int* in_sizes, int n_in, void* d_out, int out_size, void* d_ws, size_t ws_size, hipStream_t stream) {
    static int grid = 0;
    if (grid == 0) {
        if (n_in != 24 || in_sizes[0] != 4 * SEQP * DM || out_size != NTOK * DM || ws_size < WS_END) { fprintf(stderr, "kernel_launch: unexpected shapes / workspace (n_in %d, ws %zu); nothing launched\n", n_in, ws_size); grid = -1; return; }
        int dev = 0, cus = 0, per_cu = 0;
        if (hipGetDevice(&dev) != hipSuccess || hipDeviceGetAttribute(&cus, hipDeviceAttributeMultiprocessorCount, dev) != hipSuccess) { grid = -1; return; }
        if (hipFuncSetAttribute((const void*)fwd_kernel, hipFuncAttributeMaxDynamicSharedMemorySize, LDS_BYTES) != hipSuccess) { fprintf(stderr, "kernel_launch: hipFuncSetAttribute failed\n"); grid = -1; return; }
        if (hipOccupancyMaxActiveBlocksPerMultiprocessor(&per_cu, (const void*)fwd_kernel, NWAVES * 64, LDS_BYTES) != hipSuccess || per_cu < 1) { fprintf(stderr, "kernel_launch: occupancy query says %d\n", per_cu); }
        (void)hipGetLastError();
        grid = cus;
    }
    if (grid < 0) return;
    if (hipMemsetAsync((char*)d_ws + WS_CTL, 0, CTL_ZERO_BYTES, stream) != hipSuccess) return;
    Args a{};
    for (int i = 0; i < 24; ++i) a.in[i] = (const float*)d_in[i];
    a.out = (float*)d_out; a.ws = (unsigned char*)d_ws;
#if MK_SINGLE
    a.ph_lo = 0; a.ph_hi = NPHASE;
    hipLaunchKernelGGL(fwd_kernel, dim3(grid), dim3(NWAVES * 64), LDS_BYTES, stream, a);
#else
    for (int p = 0; p < NPHASE; ++p) { a.ph_lo = p; a.ph_hi = p + 1; hipLaunchKernelGGL(fwd_kernel, dim3(grid), dim3(NWAVES * 64), LDS_BYTES, stream, a); }
#endif
}
```

```cpp
#include <hip/hip_runtime.h>
#include <cstdio>
#include <cstdint>

#ifndef MK_SINGLE
#define MK_SINGLE 1
#endif

template <int K> __device__ __forceinline__ float shx(float v) {
    if constexpr (K == 32) { const unsigned u = __builtin_bit_cast(unsigned, v); auto rr = __builtin_amdgcn_permlane32_swap(u, u, false, false);
        return __builtin_bit_cast(float, (threadIdx.x & 32) ? rr[0] : rr[1]); }
    else return __builtin_bit_cast(float, __builtin_amdgcn_ds_swizzle(__builtin_bit_cast(int, v), (K << 10) | 0x1f));
}
namespace pg8 {
#define PG8_LAS __attribute__((address_space(3)))
typedef unsigned short bf16_t;
typedef short bf16x8 __attribute__((ext_vector_type(8)));
typedef float f32x4 __attribute__((ext_vector_type(4)));
typedef unsigned u32x4 __attribute__((ext_vector_type(4)));
constexpr int BM = 256, BK = 64, HALF = 128, HTB = HALF * BK * 2  , STAGE_BYTES = 8 * HTB, NXCD = 8, WGM = 8;

__host__ __device__ __forceinline__ int lds_byte(int r, int c) { const int st = (r >> 4) * 2 + (c >> 5), rr = r & 15, cc = c & 31, ob = rr * 64 + cc * 2; return st * 1024 + (ob ^ (((ob >> 9) & 1) << 5)); }
__host__ __device__ __forceinline__ void stage_rc(int b, int& R, int& C) { const int st = b / 1024, sb = b % 1024, swz = sb ^ (((sb >> 9) & 1) << 5); R = (st >> 1) * 16 + swz / 64; C = (st & 1) * 32 + (swz % 64) / 2; }
__host__ __device__ __forceinline__ int perm32(int rho) { const int n = rho >> 4, i = rho & 15; return 8 * (i >> 2) + 4 * n + (i & 3); }

struct Unit { int pm, pn; };
struct Gemm { const bf16_t* A; const bf16_t* Bt; int M, N, K; };

struct StaticOrder {
    int nM, nN, nwg, G, c;
    __host__ __device__ void init(int M, int N, int G_, int c_) { nM = M / BM; nN = N / BM; nwg = nM * nN; G = G_; c = c_; }
    __host__ __device__ bool next(int i, Unit& u) const {
        const long L = (long)i * G + c; if (L >= nwg) return false;
        int wgid = (int)L; { const int q = nwg / NXCD, r = nwg % NXCD, xcd = wgid % NXCD, off = wgid / NXCD; wgid = (xcd < r ? xcd * (q + 1) : r * (q + 1) + (xcd - r) * q) + off; }
        const int nig = WGM * nN, gid = wgid / nig, fm = gid * WGM, gsz = (nM - fm) < WGM ? (nM - fm) : WGM;
        u.pm = fm + ((wgid % nig) % gsz); u.pn = (wgid % nig) / gsz; return true;
    }
    __device__ __forceinline__ void a_ready(const Unit&) const {}
    __device__ __forceinline__ void done(const Unit&) const {}
};
typedef float f32x2_t __attribute__((ext_vector_type(2))); typedef __bf16 bf16x2_t __attribute__((ext_vector_type(2)));
__device__ __forceinline__ unsigned cvt_pk_bf16(float lo, float hi) { f32x2_t v = {lo, hi}; bf16x2_t b = __builtin_convertvector(v, bf16x2_t); return __builtin_bit_cast(unsigned, b); }
__device__ __forceinline__ float bflo(unsigned w) { return __builtin_bit_cast(float, w << 16); }
__device__ __forceinline__ float bfhi(unsigned w) { return __builtin_bit_cast(float, w & 0xffff0000u); }
__device__ __forceinline__ float fast_sigmoid(float x) { return __builtin_amdgcn_rcpf(1.f + __builtin_amdgcn_exp2f(-1.4426950408889634f * x)); }
constexpr float C2 = 0.125f * 1.4426950408889634f;
__host__ __device__ __forceinline__ size_t kt_index(int row, int col) { const int h = col >> 7, m = (col >> 6) & 1, c = (col >> 3) & 7;
    return ((((size_t)(row >> 6) * 16 + h) * 2 + m) * 8 + c) * 512 + (size_t)(row & 63) * 8 + (col & 7); }
__host__ __device__ __forceinline__ size_t vt_index(int row, int col) { const int h = col >> 7, cv = col & 127;
    return ((((size_t)(row >> 6) * 16 + h) * 16 + (cv >> 5) * 4 + ((row >> 4) & 3)) * 16 + (row & 15)) * 32 + (cv & 31); }
struct EpiInA {
    static constexpr bool PERM = true, AFTER_DRAIN = false;
    bf16_t *Q, *K, *V, *SL; const float* rope;
    __device__ __forceinline__ void operator()(const f32x4 (&acc)[2][2][4][2], const Unit& u, int wr, int wc, int fr, int fq) const {
        const int pn = u.pn, row0 = u.pm * BM + wr * 64 + fr;
        if (pn < 16) {
            const float sc = pn < 8 ? C2 : 1.f; const int colt = (pn & 7) * BM + wc * 32 + 8 * fq;
#pragma unroll
            for (int ai = 0; ai < 2; ++ai)
#pragma unroll
                for (int m = 0; m < 4; ++m) { const int row = row0 + ai * HALF + m * 16; const int pos = row < 16384 ? (row & 4095) : (row - 16384);
#pragma unroll
                    for (int bj = 0; bj < 2; ++bj) { const int i0 = ((colt + bj * HALF) & 63) >> 1; bf16_t* dst = pn < 8 ? Q + (size_t)row * 2048 + colt + bj * HALF : K + kt_index(row, colt + bj * HALF);
                        const f32x4* tp = (const f32x4*)(rope + ((size_t)pos * 32 + i0) * 2); const f32x4 t0 = tp[0], t1 = tp[1];
                        const f32x4 v0 = acc[ai][bj][m][0], v1 = acc[ai][bj][m][1]; u32x4 w;
                        w.x = cvt_pk_bf16((v0[0] * t0[0] - v0[1] * t0[1]) * sc, (v0[1] * t0[0] + v0[0] * t0[1]) * sc);
                        w.y = cvt_pk_bf16((v0[2] * t0[2] - v0[3] * t0[3]) * sc, (v0[3] * t0[2] + v0[2] * t0[3]) * sc);
                        w.z = cvt_pk_bf16((v1[0] * t1[0] - v1[1] * t1[1]) * sc, (v1[1] * t1[0] + v1[0] * t1[1]) * sc);
                        w.w = cvt_pk_bf16((v1[2] * t1[2] - v1[3] * t1[3]) * sc, (v1[3] * t1[2] + v1[2] * t1[3]) * sc);
                        *(u32x4*)dst = w; __builtin_amdgcn_sched_barrier(0); } }
        } else {
            bf16_t* base; int ldc, colt;
            if (pn < 24) { base = V; ldc = 2048; colt = (pn - 16) * BM; } else { base = SL; ldc = 6656; colt = (pn - 24) * BM; }
            colt += wc * 32 + 8 * fq;
#pragma unroll
            for (int ai = 0; ai < 2; ++ai)
#pragma unroll
                for (int m = 0; m < 4; ++m) { const int row = row0 + ai * HALF + m * 16;
#pragma unroll
                    for (int bj = 0; bj < 2; ++bj) { const f32x4 v0 = acc[ai][bj][m][0], v1 = acc[ai][bj][m][1]; u32x4 w;
                        w.x = cvt_pk_bf16(v0[0], v0[1]); w.y = cvt_pk_bf16(v0[2], v0[3]); w.z = cvt_pk_bf16(v1[0], v1[1]); w.w = cvt_pk_bf16(v1[2], v1[3]);
                        bf16_t* dst = pn < 24 ? base + vt_index(row, colt + bj * HALF) : base + (size_t)row * ldc + colt + bj * HALF;
                        *(u32x4*)dst = w; __builtin_amdgcn_sched_barrier(0); } }
        }
    }
};
struct EpiZ {
    static constexpr bool PERM = true, AFTER_DRAIN = false;
    bf16_t *YA, *YB;
    __device__ __forceinline__ void operator()(const f32x4 (&acc)[2][2][4][2], const Unit& u, int wr, int wc, int fr, int fq) const {
        const int pn = u.pn, row0 = u.pm * BM + wr * 64 + fr;
        bf16_t* base = pn < 8 ? YA : YB; const int colt = (pn & 7) * BM + wc * 32 + 8 * fq;
#pragma unroll
        for (int ai = 0; ai < 2; ++ai)
#pragma unroll
            for (int m = 0; m < 4; ++m) { bf16_t* rowp = base + (size_t)(row0 + ai * HALF + m * 16) * 2048 + colt;
#pragma unroll
                for (int bj = 0; bj < 2; ++bj) { const f32x4 v0 = acc[ai][bj][m][0], v1 = acc[ai][bj][m][1]; const u32x4 y = *(const u32x4*)(rowp + bj * HALF); u32x4 w;
                    w.x = cvt_pk_bf16(bflo(y.x) * v0[0] * fast_sigmoid(v0[0]), bfhi(y.x) * v0[1] * fast_sigmoid(v0[1]));
                    w.y = cvt_pk_bf16(bflo(y.y) * v0[2] * fast_sigmoid(v0[2]), bfhi(y.y) * v0[3] * fast_sigmoid(v0[3]));
                    w.z = cvt_pk_bf16(bflo(y.z) * v1[0] * fast_sigmoid(v1[0]), bfhi(y.z) * v1[1] * fast_sigmoid(v1[1]));
                    w.w = cvt_pk_bf16(bflo(y.w) * v1[2] * fast_sigmoid(v1[2]), bfhi(y.w) * v1[3] * fast_sigmoid(v1[3]));
                    *(u32x4*)(rowp + bj * HALF) = w; __builtin_amdgcn_sched_barrier(0); } }
    }
};
struct EpiG {
    static constexpr bool PERM = true, AFTER_DRAIN = false;
    bf16_t* G;
    __device__ __forceinline__ void operator()(const f32x4 (&acc)[2][2][4][2], const Unit& u, int wr, int wc, int fr, int fq) const {
        const int row0 = u.pm * BM + wr * 64 + fr, colt = u.pn * BM + wc * 32 + 8 * fq;
#pragma unroll
        for (int ai = 0; ai < 2; ++ai)
#pragma unroll
            for (int m = 0; m < 4; ++m) { bf16_t* rowp = G + (size_t)(row0 + ai * HALF + m * 16) * 8192 + colt;
#pragma unroll
                for (int bj = 0; bj < 2; ++bj) { const f32x4 v0 = acc[ai][bj][m][0], v1 = acc[ai][bj][m][1]; u32x4 w;
                    w.x = cvt_pk_bf16(fast_sigmoid(v0[0]), fast_sigmoid(v0[1])); w.y = cvt_pk_bf16(fast_sigmoid(v0[2]), fast_sigmoid(v0[3]));
                    w.z = cvt_pk_bf16(fast_sigmoid(v1[0]), fast_sigmoid(v1[1])); w.w = cvt_pk_bf16(fast_sigmoid(v1[2]), fast_sigmoid(v1[3]));
                    *(u32x4*)(rowp + bj * HALF) = w; __builtin_amdgcn_sched_barrier(0); } }
    }
};
template <bool SECOND> struct EpiM {
    static constexpr bool PERM = true, AFTER_DRAIN = false;
    bf16_t* Mb; const bf16_t* G;
    __device__ __forceinline__ void operator()(const f32x4 (&acc)[2][2][4][2], const Unit& u, int wr, int wc, int fr, int fq) const {
        const int row0 = u.pm * BM + wr * 64 + fr, colt = u.pn * BM + wc * 32 + 8 * fq;
#pragma unroll
        for (int ai = 0; ai < 2; ++ai)
#pragma unroll
            for (int m = 0; m < 4; ++m) { const size_t row = (size_t)(row0 + ai * HALF + m * 16); bf16_t* rowp = Mb + row * 4096 + colt; const bf16_t* gp = G + row * 8192 + (SECOND ? 4096 : 0) + colt;
#pragma unroll
                for (int bj = 0; bj < 2; ++bj) { const f32x4 v0 = acc[ai][bj][m][0], v1 = acc[ai][bj][m][1]; const u32x4 g = *(const u32x4*)(gp + bj * HALF);
                    float o[8] = {bflo(g.x) * v0[0], bfhi(g.x) * v0[1], bflo(g.y) * v0[2], bfhi(g.y) * v0[3], bflo(g.z) * v1[0], bfhi(g.z) * v1[1], bflo(g.w) * v1[2], bfhi(g.w) * v1[3]};
                    if (SECOND) { const u32x4 p = *(const u32x4*)(rowp + bj * HALF);
                        o[0] += bflo(p.x); o[1] += bfhi(p.x); o[2] += bflo(p.y); o[3] += bfhi(p.y); o[4] += bflo(p.z); o[5] += bfhi(p.z); o[6] += bflo(p.w); o[7] += bfhi(p.w); }
                    u32x4 w; w.x = cvt_pk_bf16(o[0], o[1]); w.y = cvt_pk_bf16(o[2], o[3]); w.z = cvt_pk_bf16(o[4], o[5]); w.w = cvt_pk_bf16(o[6], o[7]);
                    *(u32x4*)(rowp + bj * HALF) = w; __builtin_amdgcn_sched_barrier(0); } }
    }
};
struct EpiOut {
    static constexpr bool PERM = true, AFTER_DRAIN = false;
    const float *xp, *xs; bf16_t* pre; float* part;
    __device__ __forceinline__ void operator()(const f32x4 (&acc)[2][2][4][2], const Unit& u, int wr, int wc, int fr, int fq) const {
        const int row0 = u.pm * BM + wr * 64 + fr, colt = u.pn * BM + wc * 32 + 8 * fq;
#pragma unroll
        for (int ai = 0; ai < 2; ++ai)
#pragma unroll
            for (int m = 0; m < 4; ++m) { const int row = row0 + ai * HALF + m * 16;
                const float* xr = (row < 16384 ? xp + (size_t)row * 4096 : xs + (size_t)(row - 16384) * 4096) + colt; bf16_t* orow = pre + (size_t)row * 4096 + colt; float ss = 0.f;
#pragma unroll
                for (int bj = 0; bj < 2; ++bj) { const f32x4 a0 = *(const f32x4*)(xr + bj * HALF), a1 = *(const f32x4*)(xr + bj * HALF + 4);
                    const f32x4 o0 = a0 + acc[ai][bj][m][0], o1 = a1 + acc[ai][bj][m][1];
                    ss += (o0[0] * o0[0] + o0[1] * o0[1]) + (o0[2] * o0[2] + o0[3] * o0[3]) + (o1[0] * o1[0] + o1[1] * o1[1]) + (o1[2] * o1[2] + o1[3] * o1[3]);
                    u32x4 w; w.x = cvt_pk_bf16(o0[0], o0[1]); w.y = cvt_pk_bf16(o0[2], o0[3]); w.z = cvt_pk_bf16(o1[0], o1[1]); w.w = cvt_pk_bf16(o1[2], o1[3]); *(u32x4*)(orow + bj * HALF) = w; }
                ss += shx<16>(ss); ss += shx<32>(ss);
                if (fq == 0) part[(size_t)row * 64 + u.pn * 4 + wc] = ss; }
    }
};
template <class Epi, class Sched, bool ALIGN_EPI = false, bool SP2 = false>
__device__ __forceinline__ void gemm_phase(PG8_LAS unsigned char* lds, const Gemm g, const Sched& S, const Epi& E) {
    const int tid = threadIdx.x, wid = __builtin_amdgcn_readfirstlane(tid >> 6), lane = tid & 63, wr = wid >> 2, wc = wid & 3, fr = lane & 15, fq = lane >> 4;
    const int K = g.K, nt = K / BK;
    unsigned voffA[2], voffB[2];
#pragma unroll
    for (int i = 0; i < 2; ++i) { int R, C; stage_rc(tid * 16 + i * 8192, R, C); const int Rb = Epi::PERM ? ((R & ~31) + perm32(R & 31)) : R;
        voffA[i] = (unsigned)(R * K + C) * 2u; voffB[i] = (unsigned)(Rb * K + C) * 2u; }
    const size_t kstep = (size_t)(BK * 2);
    const size_t hstep = (size_t)HALF * K * 2;
    const size_t tstep = 2 * hstep;
    const unsigned ldsw = (unsigned)wid * 1024u;
    const int aoff = lds_byte(wr * 64 + fr, fq * 8), boff = lds_byte(wc * 32 + fr, fq * 8);
#define PG8_SA(b, h) (((b) * 2 + (h)) * HTB)
#define PG8_SB(b, h) ((4 + (b) * 2 + (h)) * HTB)
#define PG8_STAGE(bufoff, gbase, voff) do { _Pragma("unroll") for (int _i = 0; _i < 2; ++_i) \
        __builtin_amdgcn_global_load_lds((const unsigned*)((const char*)(gbase) + (voff)[_i]), (PG8_LAS unsigned*)(lds + (bufoff) + ldsw + _i * 8192), 16, 0, 0); } while (0)
#define PG8_LDA(dst, b, h) do { _Pragma("unroll") for (int m = 0; m < 4; ++m) _Pragma("unroll") for (int k = 0; k < 2; ++k) dst[m][k] = *(const PG8_LAS bf16x8*)(lds + PG8_SA(b, h) + aoff + m * 2048 + k * 1024); } while (0)
#define PG8_LDB(dst, b, h) do { _Pragma("unroll") for (int n = 0; n < 2; ++n) _Pragma("unroll") for (int k = 0; k < 2; ++k) dst[n][k] = *(const PG8_LAS bf16x8*)(lds + PG8_SB(b, h) + boff + n * 2048 + k * 1024); } while (0)
#define PG8_MMA(ai, bj, At, Bt) do { __builtin_amdgcn_s_setprio(1); _Pragma("unroll") for (int m = 0; m < 4; ++m) _Pragma("unroll") for (int n = 0; n < 2; ++n) _Pragma("unroll") for (int k = 0; k < 2; ++k) \
        acc[ai][bj][m][n] = __builtin_amdgcn_mfma_f32_16x16x32_bf16(Bt[n][k], At[m][k], acc[ai][bj][m][n], 0, 0, 0); __builtin_amdgcn_s_setprio(0); } while (0)
#define PG8_WAIT_V(n) asm volatile("s_waitcnt vmcnt(" #n ")" ::: "memory")
#define PG8_WAIT_L(n) asm volatile("s_waitcnt lgkmcnt(" #n ")" ::: "memory")
#define PG8_BAR __builtin_amdgcn_s_barrier()
#define PG8_SCHED __builtin_amdgcn_sched_barrier(0)
    Unit cur, nxt; int ui = 0;
    if (!S.next(0, cur)) return;
    f32x4 acc[2][2][4][2];
#pragma unroll
    for (int a = 0; a < 2; ++a)
#pragma unroll
        for (int b = 0; b < 2; ++b)
#pragma unroll
            for (int m = 0; m < 4; ++m)
#pragma unroll
                for (int n = 0; n < 2; ++n) acc[a][b][m][n] = (f32x4){0.f, 0.f, 0.f, 0.f};
    bf16x8 At[4][2], B0[2][2], B1[2][2];
    const char* cA = (const char*)g.A + (size_t)cur.pm * tstep; const char* cB = (const char*)g.Bt + (size_t)cur.pn * tstep;
    S.a_ready(cur);
    if constexpr (SP2) {
        PG8_STAGE(PG8_SB(0, 0), cB, voffB); PG8_STAGE(PG8_SB(0, 1), cB + hstep, voffB); PG8_STAGE(PG8_SA(0, 0), cA, voffA); PG8_STAGE(PG8_SA(0, 1), cA + hstep, voffA);
        if (wr == 1) PG8_BAR;
        PG8_WAIT_V(2); PG8_BAR;
        PG8_STAGE(PG8_SB(1, 0), cB + kstep, voffB); PG8_STAGE(PG8_SA(1, 0), cA + kstep, voffA); PG8_STAGE(PG8_SB(1, 1), cB + hstep + kstep, voffB);
        PG8_WAIT_V(6); PG8_BAR;
    } else {
        PG8_STAGE(PG8_SB(0, 0), cB, voffB); PG8_STAGE(PG8_SA(0, 0), cA, voffA); PG8_STAGE(PG8_SB(0, 1), cB + hstep, voffB); PG8_STAGE(PG8_SA(0, 1), cA + hstep, voffA);
        if (wr == 1) PG8_BAR;
        PG8_WAIT_V(4); PG8_BAR;
        PG8_STAGE(PG8_SB(1, 0), cB + kstep, voffB); PG8_STAGE(PG8_SA(1, 0), cA + kstep, voffA); PG8_STAGE(PG8_SB(1, 1), cB + hstep + kstep, voffB);
        PG8_WAIT_V(6); PG8_BAR;
    }
    for (;;) {
        const bool has_next = S.next(ui + 1, nxt);
        const char* nA = has_next ? (const char*)g.A + (size_t)nxt.pm * tstep : cA; const char* nB = has_next ? (const char*)g.Bt + (size_t)nxt.pn * tstep : cB;
        for (int t = 0; t < nt; t += 2) {
            const bool last = (t == nt - 2);
            const char* a1 = cA + (size_t)(t + 1) * kstep;
            const char* a2 = last ? nA : cA + (size_t)(t + 2) * kstep; const char* b2 = last ? nB : cB + (size_t)(t + 2) * kstep;
            const char* a3 = a2 + kstep; const char* b3 = b2 + kstep;
            if (last && has_next) S.a_ready(nxt);
            if constexpr (SP2) {
            PG8_LDB(B0, 0, 0); PG8_LDB(B1, 0, 1); PG8_SCHED; PG8_LDA(At, 0, 0); PG8_STAGE(PG8_SA(1, 1), a1 + hstep, voffA);
            PG8_WAIT_V(8); PG8_WAIT_L(0); PG8_BAR; PG8_MMA(0, 0, At, B0); PG8_MMA(0, 1, At, B1); PG8_BAR; PG8_SCHED;
            PG8_LDA(At, 0, 1); PG8_STAGE(PG8_SB(0, 0), b2, voffB); PG8_STAGE(PG8_SB(0, 1), b2 + hstep, voffB); PG8_STAGE(PG8_SA(0, 0), a2, voffA);
            PG8_WAIT_V(8); PG8_WAIT_L(0); PG8_BAR; PG8_MMA(1, 0, At, B0); PG8_MMA(1, 1, At, B1); PG8_BAR; PG8_SCHED;
            PG8_LDB(B0, 1, 0); PG8_LDB(B1, 1, 1); PG8_SCHED; PG8_LDA(At, 1, 0); PG8_STAGE(PG8_SA(0, 1), a2 + hstep, voffA);
            PG8_WAIT_V(8); PG8_WAIT_L(0); PG8_BAR; PG8_MMA(0, 0, At, B0); PG8_MMA(0, 1, At, B1); PG8_BAR; PG8_SCHED;
            PG8_LDA(At, 1, 1); PG8_STAGE(PG8_SB(1, 0), b3, voffB); PG8_STAGE(PG8_SB(1, 1), b3 + hstep, voffB); PG8_STAGE(PG8_SA(1, 0), a3, voffA);
            PG8_WAIT_V(8); PG8_WAIT_L(0); PG8_BAR; PG8_MMA(1, 0, At, B0); PG8_MMA(1, 1, At, B1); PG8_BAR; PG8_SCHED;
            } else {
            PG8_LDB(B0, 0, 0); PG8_SCHED; PG8_LDA(At, 0, 0); PG8_STAGE(PG8_SA(1, 1), a1 + hstep, voffA);
            PG8_WAIT_L(8); PG8_BAR; PG8_WAIT_L(0); PG8_MMA(0, 0, At, B0); PG8_BAR; PG8_SCHED;
            PG8_LDB(B1, 0, 1); PG8_STAGE(PG8_SB(0, 0), b2, voffB);
            PG8_BAR; PG8_WAIT_L(0); PG8_MMA(0, 1, At, B1); PG8_BAR;
            PG8_LDA(At, 0, 1); PG8_STAGE(PG8_SA(0, 0), a2, voffA);
            PG8_BAR; PG8_WAIT_L(0); PG8_MMA(1, 0, At, B0); PG8_BAR; PG8_SCHED;
            PG8_STAGE(PG8_SB(0, 1), b2 + hstep, voffB);
            PG8_WAIT_V(6); PG8_BAR; PG8_MMA(1, 1, At, B1); PG8_BAR;
            PG8_LDB(B0, 1, 0); PG8_SCHED; PG8_LDA(At, 1, 0); PG8_STAGE(PG8_SA(0, 1), a2 + hstep, voffA);
            PG8_WAIT_L(8); PG8_BAR; PG8_WAIT_L(0); PG8_MMA(0, 0, At, B0); PG8_BAR; PG8_SCHED;
            PG8_LDB(B1, 1, 1); PG8_STAGE(PG8_SB(1, 0), b3, voffB);
            PG8_BAR; PG8_WAIT_L(0); PG8_MMA(0, 1, At, B1); PG8_BAR;
            PG8_LDA(At, 1, 1); PG8_STAGE(PG8_SA(1, 0), a3, voffA);
            PG8_BAR; PG8_WAIT_L(0); PG8_MMA(1, 0, At, B0); PG8_BAR; PG8_SCHED;
            PG8_STAGE(PG8_SB(1, 1), b3 + hstep, voffB);
            PG8_WAIT_V(6); PG8_BAR; PG8_MMA(1, 1, At, B1); PG8_BAR;
            }
        }
        if constexpr (ALIGN_EPI) { if (wr == 0) PG8_BAR; }
        if constexpr (!Epi::AFTER_DRAIN) { E(acc, cur, wr, wc, fr, fq); S.done(cur); }
        if (!has_next) break;
#pragma unroll
        for (int a = 0; a < 2; ++a)
#pragma unroll
            for (int b = 0; b < 2; ++b)
#pragma unroll
                for (int m = 0; m < 4; ++m)
#pragma unroll
                    for (int n = 0; n < 2; ++n) acc[a][b][m][n] = (f32x4){0.f, 0.f, 0.f, 0.f};
        cur = nxt; cA = nA; cB = nB; ++ui;
        if constexpr (ALIGN_EPI) { if (wr == 1) PG8_BAR; }
    }
    PG8_WAIT_V(0);
    if constexpr (!ALIGN_EPI) { if (wr == 0) PG8_BAR; }
    PG8_BAR;
    if constexpr (Epi::AFTER_DRAIN) { E.fused(acc, cur, wr, wc, fr, fq, lds, wid, lane); S.done(cur); }
#undef PG8_SA
#undef PG8_SB
#undef PG8_STAGE
#undef PG8_LDA
#undef PG8_LDB
#undef PG8_MMA
#undef PG8_WAIT_V
#undef PG8_WAIT_L
#undef PG8_BAR
#undef PG8_SCHED
}
}
typedef unsigned u32x4 __attribute__((ext_vector_type(4)));
#define GAS __attribute__((address_space(1)))
#define LAS __attribute__((address_space(3)))
typedef unsigned short bf16;
typedef unsigned v4u __attribute__((ext_vector_type(4)));
typedef float f32x4 __attribute__((ext_vector_type(4)));
typedef short bf16x8 __attribute__((ext_vector_type(8)));
typedef GAS unsigned gu32;
typedef GAS unsigned long long gu64;
#define RLX_AGENT __ATOMIC_RELAXED, __HIP_MEMORY_SCOPE_AGENT
#define LDS_WAIT() asm volatile("s_waitcnt lgkmcnt(0)" ::: "memory")
#define VM_WAIT() asm volatile("s_waitcnt vmcnt(0)" ::: "memory")
__device__ __forceinline__ unsigned long long rt() { return __builtin_amdgcn_s_memrealtime(); }
__device__ __forceinline__ unsigned f2bf(float f) { unsigned u = __builtin_bit_cast(unsigned, f); return (u + 0x7fffu + ((u >> 16) & 1u)) >> 16; }
__device__ __forceinline__ unsigned pk2(float lo, float hi) { return f2bf(lo) | (f2bf(hi) << 16); }
#define XB_TMO      128
#define XB_XCNT(j)  (256  + 64 * (j))
#define XB_XSUB(j)  (1280 + 64 * (j))
#define XB_XGEN(j)  (2304 + 64 * (j))
#define XB_TOP      3328
#define XB_TOPGEN   3392
#define XCD_BAR_WORDS 3456
#define XB_SPIN_CAP (1u << 21)

__device__ __forceinline__ unsigned xb_ld(unsigned* p)              { return __hip_atomic_load(p, __ATOMIC_RELAXED, __HIP_MEMORY_SCOPE_AGENT); }
__device__ __forceinline__ unsigned xb_add(unsigned* p, unsigned v) { return __hip_atomic_fetch_add(p, v, __ATOMIC_RELAXED, __HIP_MEMORY_SCOPE_AGENT); }
__device__ __forceinline__ unsigned xb_xcc_id() { return (unsigned)__builtin_amdgcn_s_getreg((3 << 11) | 20) & 0xFu; }
#define XB_SPIN(cond, bar) do { unsigned _sp = 0; while (cond) { __builtin_amdgcn_s_sleep(1); \
    if ((++_sp & 255u) == 0u) { if (xb_ld(&(bar)[XB_TMO])) break; if (_sp > XB_SPIN_CAP) { atomicAdd(&(bar)[XB_TMO], 1u); break; } } } } while (0)

struct XcdBarrier {
    unsigned* bar; unsigned x;
    volatile LAS unsigned* st;
};

__device__ __forceinline__ XcdBarrier xcd_barrier_post(unsigned* bar, volatile LAS unsigned* st) {
    XcdBarrier b; b.bar = bar; b.x = xb_xcc_id(); b.st = st;
    if (threadIdx.x == 0) (void)xb_add(&bar[XB_XCNT(b.x)], 1u);
    return b;
}
__device__ __forceinline__ void xcd_barrier_complete(unsigned* bar, unsigned x, unsigned& nloc, unsigned& nx) {
    const unsigned G = gridDim.x * gridDim.y * gridDim.z;
    unsigned sum, cnt, mine, sp = 0u;
    for (;;) {
        sum = 0u; cnt = 0u; mine = 0u;
#pragma unroll
        for (unsigned j = 0; j < 16; ++j) { const unsigned c = xb_ld(&bar[XB_XCNT(j)]); sum += c; cnt += (c > 0u) ? 1u : 0u; mine = (j == x) ? c : mine; }
        if (sum == G) break;
        __builtin_amdgcn_s_sleep(1);
        if ((++sp & 255u) == 0u) { if (xb_ld(&bar[XB_TMO])) break; if (sp > XB_SPIN_CAP) { atomicAdd(&bar[XB_TMO], 1u); break; } }
    }
    nloc = mine > 0u ? mine : 1u; nx = cnt > 0u ? cnt : 1u;
}

__device__ __forceinline__ void xcd_barrier(const XcdBarrier& b) {
    asm volatile("s_waitcnt vmcnt(0)" ::: "memory");
    __syncthreads();
    if (threadIdx.x == 0) {
        unsigned* bar = b.bar;
        __builtin_amdgcn_s_waitcnt(0);
        unsigned nloc = b.st[0], nx = b.st[1];
        if (nloc == 0u) { xcd_barrier_complete(bar, b.x, nloc, nx); b.st[0] = nloc; b.st[1] = nx; }
        const unsigned old = xb_add(&bar[XB_XSUB(b.x)], 1u);
        const unsigned gen = old / nloc;
        if (old + 1u == (gen + 1u) * nloc) {
            __builtin_amdgcn_fence(__ATOMIC_RELEASE, "agent");
            asm volatile("s_waitcnt vmcnt(0)" ::: "memory");
            const unsigned og = xb_add(&bar[XB_TOP], 1u);
            const unsigned tg = og / nx;
            if (og + 1u == (tg + 1u) * nx) xb_add(&bar[XB_TOPGEN], 1u);
            else XB_SPIN(xb_ld(&bar[XB_TOPGEN]) == tg, bar);
            __builtin_amdgcn_fence(__ATOMIC_ACQUIRE, "agent");
            xb_add(&bar[XB_XGEN(b.x)], 1u);
            asm volatile("s_waitcnt vmcnt(0)" ::: "memory");
        } else {
            XB_SPIN(xb_ld(&bar[XB_XGEN(b.x)]) == gen, bar);
            __builtin_amdgcn_fence(__ATOMIC_ACQUIRE, "agent");
            asm volatile("s_waitcnt vmcnt(0)" ::: "memory");
        }
    }
    __syncthreads();
}
constexpr int NWAVES = 8;
constexpr int NTOK = 32768, DM = 4096, NIN = 25088, N_A = 12800, N_B = 12288, WA = 2048, CSH = 6656, SEQP = 4096, SEQS = 16384;
constexpr size_t MiB = 1u << 20;
constexpr size_t WS_CTL = 0, CTL_ZERO_BYTES = 1 * MiB;
constexpr size_t WS_ROPE = 2 * MiB;
constexpr size_t WS_LORA = 6 * MiB;
constexpr size_t WS_BONUS = 8 * MiB;
constexpr size_t WS_PART = 16 * MiB;
constexpr size_t WS_WOA = 24 * MiB, WS_WOB = 40 * MiB, WS_WOUT = 56 * MiB;
constexpr size_t WS_WIN = 88 * MiB;
constexpr size_t WS_H = 284 * MiB;
constexpr size_t WS_Q = 540 * MiB, WS_K = 668 * MiB, WS_V = 796 * MiB;
constexpr size_t WS_SLAB = 924 * MiB;
constexpr size_t WS_YB = 1340 * MiB;
constexpr size_t WS_LIN = 1468 * MiB;
constexpr size_t WS_END = 1500 * MiB;
constexpr size_t WS_M = WS_SLAB;
constexpr int CW_QUEUE = 64;
constexpr int CW_POS = 1024;
constexpr int CW_BAR = 4096;
constexpr int RING_OFF = 0, RING_BYTES = 143360;
constexpr int MISC_OFF = RING_BYTES;
constexpr int LDS_BYTES = 147456;

struct Frame {
    LAS unsigned char* lds;
    volatile LAS unsigned* MISC;
    gu32* ctl;
    int tid, lane, wave, vcu, G;
};
__device__ __forceinline__ float wave_sum(float v) {
    v += shx<1>(v); v += shx<2>(v); v += shx<4>(v); v += shx<8>(v); v += shx<16>(v); v += shx<32>(v);
    return v;
}
__device__ __forceinline__ float bf2f(bf16 b) { return __builtin_bit_cast(float, (unsigned)b << 16); }

__device__ __forceinline__ void p0_transpose_item(const float* W, int K, int N, bf16* WT, LAS float* scr, int item, int lane, bool permqk) {
    const int nblk = N / 32, kb = item / nblk, nb = item % nblk, k0 = 64 * kb, n0 = 32 * nb;
    int nsrc = n0 + (lane & 31);
    if (permqk && n0 < 4096) { const int dp = nsrc & 63; nsrc = (nsrc & ~63) + ((dp & 1) ? 32 + (dp >> 1) : (dp >> 1)); }
#pragma unroll 8
    for (int i = 0; i < 32; ++i) { const int kk = 2 * i + (lane >> 5); scr[kk * 33 + (lane & 31)] = W[(size_t)(k0 + kk) * N + nsrc]; }
    LDS_WAIT(); asm volatile("" ::: "memory");
    const int c = lane & 7;
#pragma unroll
    for (int j = 0; j < 4; ++j) { const int n = (lane >> 3) + 8 * j; const LAS float* s = scr + (8 * c) * 33 + n;
        v4u o; o.x = pk2(s[0 * 33], s[1 * 33]); o.y = pk2(s[2 * 33], s[3 * 33]); o.z = pk2(s[4 * 33], s[5 * 33]); o.w = pk2(s[6 * 33], s[7 * 33]);
        *(GAS v4u*)(WT + (size_t)(n0 + n) * K + k0 + 8 * c) = o; }
    LDS_WAIT(); asm volatile("" ::: "memory");
}
__device__ __forceinline__ void rms_row_to_bf16(const float* xrow, const float* g, bf16* orow, int lane) {
    const GAS f32x4* xr = (const GAS f32x4*)xrow + lane; const GAS f32x4* gr = (const GAS f32x4*)g + lane;
    f32x4 v[16]; float s = 0.f;
#pragma unroll
    for (int j = 0; j < 16; ++j) { v[j] = xr[64 * j]; s += (v[j].x * v[j].x + v[j].y * v[j].y) + (v[j].z * v[j].z + v[j].w * v[j].w); }
    const float rs = 1.f / sqrtf(wave_sum(s) * (1.f / 4096.f) + 1e-6f);
    GAS unsigned long long* o8 = (GAS unsigned long long*)orow + lane;
#pragma unroll
    for (int j = 0; j < 16; ++j) { const f32x4 gg = gr[64 * j];
        o8[64 * j] = (unsigned long long)pk2(v[j].x * rs * gg.x, v[j].y * rs * gg.y) | ((unsigned long long)pk2(v[j].z * rs * gg.z, v[j].w * rs * gg.w) << 32); }
}
namespace att {
typedef short s16x4 __attribute__((ext_vector_type(4)));
typedef short v4i16_t __attribute__((ext_vector_type(4)));
typedef float f32x16 __attribute__((ext_vector_type(16)));
constexpr int ST_K2 = 8192, KV_SLOT = 16384, K_RING = 0, V_RING = 4 * KV_SLOT, NSTG = 4, ST_BYTES = 32768;
constexpr int X_OFF = 0, WSF_OFF = 8 * KV_SLOT;
constexpr float THR = 5.f;
__device__ __forceinline__ int crow(int r, int hi) { return (r & 3) + 8 * (r >> 2) + 4 * hi; }
__device__ __forceinline__ s16x4 vtr(const LAS unsigned char* p) { return __builtin_bit_cast(s16x4, __builtin_amdgcn_ds_read_tr16_b64_v4i16((LAS v4i16_t*)p)); }
#define ATT_WAITBAR() asm volatile("s_waitcnt vmcnt(0) lgkmcnt(0)\n\ts_barrier" ::: "memory")
__device__ __forceinline__ void qkt(f32x16& p0, f32x16& p1, const LAS unsigned char* kst, const bf16x8 (&qr)[4], const f32x16& negm) {
#pragma unroll
    for (int d0 = 0; d0 < 4; ++d0) {
        const bf16x8 a0 = *(const LAS bf16x8*)(kst + d0 * 2048), a1 = *(const LAS bf16x8*)(kst + d0 * 2048 + 512);
        if (d0 == 0) { p0 = __builtin_amdgcn_mfma_f32_32x32x16_bf16(a0, qr[0], negm, 0, 0, 0); p1 = __builtin_amdgcn_mfma_f32_32x32x16_bf16(a1, qr[0], negm, 0, 0, 0); }
        else { p0 = __builtin_amdgcn_mfma_f32_32x32x16_bf16(a0, qr[d0], p0, 0, 0, 0); p1 = __builtin_amdgcn_mfma_f32_32x32x16_bf16(a1, qr[d0], p1, 0, 0, 0); }
    }
}
template <int CTRL> __device__ __forceinline__ float adpp(float x) { return __builtin_bit_cast(float, __builtin_amdgcn_update_dpp(0, __builtin_bit_cast(int, x), CTRL, 0xf, 0xf, false)); }
__device__ __forceinline__ float asum16(float v) { v += adpp<0xB1>(v); v += adpp<0x4E>(v); v += adpp<0x141>(v); v += adpp<0x140>(v); return v; }
__device__ __forceinline__ float rowmax32(const f32x16& p0, const f32x16& p1) {
    float a = fmaxf(p0[0], p1[0]), b = fmaxf(p0[1], p1[1]);
#pragma unroll
    for (int r = 2; r < 16; r += 2) { a = fmaxf(a, fmaxf(p0[r], p1[r])); b = fmaxf(b, fmaxf(p0[r + 1], p1[r + 1])); }
    a = fmaxf(a, b);
    return fmaxf(a, shx<32>(a));
}

__device__ __forceinline__ void attn_unit(LAS unsigned char* lds, const bf16* Q, const bf16* K, const bf16* V, bf16* O, int rb, int Ls, int h, int q0, const LAS float* lamp, const float* subln_g) {
    int tid = threadIdx.x; asm volatile("" : "+v"(tid));
    const int lane = tid & 63, r32 = lane & 31, hi = lane >> 5; const int wid = __builtin_amdgcn_readfirstlane(tid >> 6);
    const int qg = wid >> 1, c = wid & 1;
    LAS float* wsf = (LAS float*)(lds + WSF_OFF) + wid * 64;
    bf16x8 qr[4];
    { const bf16* qp = Q + (size_t)(rb + q0 + qg * 32 + r32) * 2048 + h * 128 + c * 64 + hi * 8;
#pragma unroll
      for (int d0 = 0; d0 < 4; ++d0) qr[d0] = *(const bf16x8*)(qp + d0 * 16); }
    const bf16* src[4]; int dsto[4];
#pragma unroll
    for (int i = 0; i < 4; ++i) { const int p = wid * 4 + i;
        if (p < 16) { src[i] = K + (((((size_t)(rb >> 6) * 16 + h) * 2 + (p >> 3)) * 8 + (p & 7)) * 64 + lane) * 8; dsto[i] = K_RING + (p < 8 ? 0 : ST_K2) + (p & 7) * 1024; }
        else { const int v = p - 16; src[i] = V + (((size_t)(rb >> 6) * 16 + h) * 16 + v) * 512 + lane * 8; dsto[i] = V_RING + v * 1024; } }
#define ATT_DMA(t) do { _Pragma("unroll") for (int i_ = 0; i_ < 4; ++i_) { unsigned keep_; const bf16* g_ = src[i_] + (size_t)(t) * 64 * 2048; const unsigned l_ = (unsigned)(size_t)(lds + ((t) & 3) * KV_SLOT + dsto[i_]); \
        asm volatile("s_mov_b32 %0, m0\n\ts_mov_b32 m0, %2\n\ts_nop 0\n\tglobal_load_lds_dwordx4 %1, off\n\ts_mov_b32 m0, %0" : "=&s"(keep_) : "v"(g_), "s"(l_) : "memory"); } } while (0)
    const int NT = Ls / 64;
    const bool kwave = wid < 4;
    ATT_DMA(0); ATT_DMA(1); if (kwave) ATT_DMA(2);
    f32x16 o[4];
#pragma unroll
    for (int d = 0; d < 4; ++d) o[d] = (f32x16){};
    const int koff = K_RING + (c ? ST_K2 : 0) + hi * 1024 + r32 * 16;
    const int voff = V_RING + (4 * hi + ((lane & 15) >> 2)) * 64 + ((lane >> 4) & 1) * 32 + (lane & 3) * 8;
    if (kwave) asm volatile("s_waitcnt vmcnt(8) lgkmcnt(0)\n\ts_barrier" ::: "memory"); else asm volatile("s_waitcnt vmcnt(4) lgkmcnt(0)\n\ts_barrier" ::: "memory");
    f32x16 pc0, pc1, pn0, pn1, negm = (f32x16){}; asm volatile("" : "+v"(negm));
    qkt(pc0, pc1, lds + koff, qr, negm);
    float m_run = rowmax32(pc0, pc1), l_run = 0.f;
#pragma unroll
    for (int r = 0; r < 16; ++r) { pc0[r] -= m_run; pc1[r] -= m_run; negm[r] = -m_run; }
    asm volatile("" : "+v"(negm));
    u32x4 pw[4];
#define ATT_LOADV(L, H, d) do { _Pragma("unroll") for (int ks_ = 0; ks_ < 4; ++ks_) { L[ks_] = vtr(st + ((d) * 4 + ks_) * 1024); H[ks_] = vtr(st + ((d) * 4 + ks_) * 1024 + 512); } } while (0)
#define ATT_PV1(d, L, H) do { _Pragma("unroll") for (int ks_ = 0; ks_ < 4; ++ks_) { const bf16x8 vf_ = (bf16x8){L[ks_][0], L[ks_][1], L[ks_][2], L[ks_][3], H[ks_][0], H[ks_][1], H[ks_][2], H[ks_][3]}; \
            o[d] = __builtin_amdgcn_mfma_f32_32x32x16_bf16(__builtin_bit_cast(bf16x8, pw[ks_]), vf_, o[d], 0, 0, 0); } } while (0)
#define ATT_SGB(m, n) __builtin_amdgcn_sched_group_barrier((m), (n), 0)
#define ATT_PV(stage_off) do { const LAS unsigned char* st = lds + (stage_off) + voff; s16x4 la[4], ha[4], lb[4], hb[4]; __builtin_amdgcn_sched_barrier(0); \
        ATT_LOADV(la, ha, 0); ATT_LOADV(lb, hb, 1); ATT_PV1(0, la, ha); ATT_LOADV(la, ha, 2); ATT_PV1(1, lb, hb); ATT_LOADV(lb, hb, 3); ATT_PV1(2, la, ha); ATT_PV1(3, lb, hb); \
        ATT_SGB(0x100, 16); ATT_SGB(0x8, 4); ATT_SGB(0x100, 8); ATT_SGB(0x8, 4); ATT_SGB(0x100, 8); ATT_SGB(0x8, 8); __builtin_amdgcn_sched_barrier(0); } while (0)
#define ATT_STEP(PC0, PC1, PN0, PN1, t, CHECK, FIRST) do { \
          \
        if (FIRST) { ATT_WAITBAR(); \
            if (kwave) { if ((t) + 3 < NT) ATT_DMA((t) + 3); if ((t) + 4 < NT) ATT_DMA((t) + 4); } else { if ((t) + 2 < NT) { ATT_DMA((t) + 2); ATT_DMA((t) + 3); } } } \
        const bool has_next = (t) + 1 < NT; \
        if (has_next) qkt(PN0, PN1, lds + (((t) + 1) & 3) * KV_SLOT + koff, qr, negm); \
          \
        const float rm = (CHECK) ? rowmax32(PC0, PC1) : 0.f; \
        if ((CHECK) && __any(rm > THR)) {                             \
            const float dl = fmaxf(rm, 0.f); m_run += dl; const float alpha = __builtin_amdgcn_exp2f(-dl); l_run *= alpha; \
            _Pragma("unroll") for (int r = 0; r < 16; ++r) { PC0[r] -= dl; PC1[r] -= dl; negm[r] = -m_run; } \
            asm volatile("" : "+v"(negm)); \
            if (has_next) { _Pragma("unroll") for (int r = 0; r < 16; ++r) { PN0[r] -= dl; PN1[r] -= dl; } } \
            if (hi == 0) wsf[r32] = alpha; \
            asm volatile("s_waitcnt lgkmcnt(0)" ::: "memory"); \
            _Pragma("unroll") for (int r = 0; r < 16; ++r) { const float a_ = wsf[crow(r, hi)]; _Pragma("unroll") for (int d = 0; d < 4; ++d) o[d][r] *= a_; } \
        } \
        float ls0 = 0.f, ls1 = 0.f; \
        _Pragma("unroll") for (int r = 0; r < 16; ++r) { PC0[r] = __builtin_amdgcn_exp2f(PC0[r]); PC1[r] = __builtin_amdgcn_exp2f(PC1[r]); ls0 += PC0[r]; ls1 += PC1[r]; } \
        l_run += ls0 + ls1; \
          \
        pw[0] = (u32x4){pg8::cvt_pk_bf16(PC0[0], PC0[1]), pg8::cvt_pk_bf16(PC0[2], PC0[3]), pg8::cvt_pk_bf16(PC0[4], PC0[5]), pg8::cvt_pk_bf16(PC0[6], PC0[7])}; \
        pw[1] = (u32x4){pg8::cvt_pk_bf16(PC0[8], PC0[9]), pg8::cvt_pk_bf16(PC0[10], PC0[11]), pg8::cvt_pk_bf16(PC0[12], PC0[13]), pg8::cvt_pk_bf16(PC0[14], PC0[15])}; \
        pw[2] = (u32x4){pg8::cvt_pk_bf16(PC1[0], PC1[1]), pg8::cvt_pk_bf16(PC1[2], PC1[3]), pg8::cvt_pk_bf16(PC1[4], PC1[5]), pg8::cvt_pk_bf16(PC1[6], PC1[7])}; \
        pw[3] = (u32x4){pg8::cvt_pk_bf16(PC1[8], PC1[9]), pg8::cvt_pk_bf16(PC1[10], PC1[11]), pg8::cvt_pk_bf16(PC1[12], PC1[13]), pg8::cvt_pk_bf16(PC1[14], PC1[15])}; \
        ATT_PV(((t) & 3) * KV_SLOT); } while (0)
    for (int t = 0; t < NT; t += 2) { ATT_STEP(pc0, pc1, pn0, pn1, t, (t & 6) == 0, true); ATT_STEP(pn0, pn1, pc0, pc1, t + 1, false, false); }
#undef ATT_LOADV
#undef ATT_PV1
#undef ATT_PV
#undef ATT_SGB
#undef ATT_STEP
    l_run += shx<32>(l_run);
    if (hi == 0) wsf[r32] = (c ? *lamp : 1.f) / l_run;
    ATT_WAITBAR();
    LAS float* X = (LAS float*)(lds + X_OFF) + qg * 4096;
    float sc[16];
#pragma unroll
    for (int r = 0; r < 16; ++r) sc[r] = wsf[crow(r, hi)];
    if (c == 1) {
#pragma unroll
        for (int d = 0; d < 4; ++d)
#pragma unroll
            for (int r = 0; r < 16; ++r) X[(d * 16 + r) * 64 + lane] = o[d][r] * sc[r];
    }
    ATT_WAITBAR();
    if (c == 0) {
        float ss[16];
#pragma unroll
        for (int r = 0; r < 16; ++r) { float s = 0.f;
#pragma unroll
            for (int d = 0; d < 4; ++d) { const float y = o[d][r] * sc[r] - X[(d * 16 + r) * 64 + lane]; o[d][r] = y; s += y * y; }
            ss[r] = s; }
#pragma unroll
        for (int r = 0; r < 16; ++r) ss[r] = asum16(ss[r]);
        float sx[16];
#pragma unroll
        for (int r = 0; r < 16; ++r) sx[r] = shx<16>(ss[r]);
        __builtin_amdgcn_sched_barrier(0);
#pragma unroll
        for (int r = 0; r < 16; ++r) ss[r] = 0.8f * __builtin_amdgcn_rsqf((ss[r] + sx[r]) * (1.f / 128.f) + 1e-5f);
        float g[4];
#pragma unroll
        for (int d = 0; d < 4; ++d) g[d] = subln_g[32 * d + r32];
#pragma unroll
        for (int r = 0; r < 16; ++r) { bf16* op = O + (size_t)(rb + q0 + qg * 32 + crow(r, hi)) * 2048 + h * 128 + r32;
#pragma unroll
            for (int d = 0; d < 4; ++d) op[32 * d] = (bf16)f2bf(o[d][r] * ss[r] * g[d]); }
    }
    ATT_WAITBAR();
#undef ATT_DMA
}
}
namespace scan1 {
constexpr int O_W = 0, O_KK = 16384, O_B = 32768, O_KD = 49152, O_R = 65536, O_V = 81920, O_TW = 98304, O_PA = 98304 + 17408, TWS = 136;
struct P { const bf16* SL; const float *mu_prev, *mu_next, *w0, *a0, *k_k, *k_a, *r_k; const bf16* LT; float* YD; float* BON; };
__device__ __forceinline__ void ld8(const bf16* p, bool ok, float (&v)[8]) {
    u32x4 w = ok ? *(const u32x4*)p : (u32x4){0u, 0u, 0u, 0u};
    v[0] = pg8::bflo(w.x); v[1] = pg8::bfhi(w.x); v[2] = pg8::bflo(w.y); v[3] = pg8::bfhi(w.y); v[4] = pg8::bflo(w.z); v[5] = pg8::bfhi(w.z); v[6] = pg8::bflo(w.w); v[7] = pg8::bfhi(w.w);
}
__device__ __forceinline__ void shift8(const P& a, int rb, int Ls, int tok, int col, float (&x)[8]) {
    const bf16* rp = a.SL + (size_t)(rb + tok) * CSH + col; float pc[8], pp[8], pn[8];
    ld8(rp, true, pc); ld8(rp - CSH, tok > 0, pp); ld8(rp + CSH, tok < Ls - 1, pn);
    const f32x4 m0 = *(const f32x4*)(a.mu_prev + col), m1 = *(const f32x4*)(a.mu_prev + col + 4), n0 = *(const f32x4*)(a.mu_next + col), n1 = *(const f32x4*)(a.mu_next + col + 4);
#pragma unroll
    for (int i = 0; i < 8; ++i) { const float mp = i < 4 ? m0[i] : m1[i - 4], mn = i < 4 ? n0[i] : n1[i - 4]; x[i] = pc[i] + mp * (pp[i] - pc[i]) + mn * (pn[i] - pc[i]); }
}
__device__ __forceinline__ void scan_item(Frame& F, const P& a, int seq, int h, int dir) {
    const int rb = seq < 4 ? seq * SEQP : 4 * SEQP, Ls = seq < 4 ? SEQP : SEQS, nch = Ls / 64;
    LAS unsigned char* lds = F.lds;
    LAS float *Wd = (LAS float*)(lds + O_W), *KKs = (LAS float*)(lds + O_KK), *Bs = (LAS float*)(lds + O_B), *KDs = (LAS float*)(lds + O_KD), *Rs = (LAS float*)(lds + O_R), *Vs = (LAS float*)(lds + O_V);
    LAS bf16 *TW = (LAS bf16*)(lds + O_TW), *PA = (LAS bf16*)(lds + O_PA);
    int tid0 = F.tid; asm volatile("" : "+v"(tid0));
    float st[64];
#pragma unroll
    for (int j = 0; j < 64; ++j) st[j] = 0.f;
    for (int ci = 0; ci < nch; ++ci) {
        int tid = tid0; asm volatile("" : "+v"(tid));
        const int lane = tid & 63, wid = __builtin_amdgcn_readfirstlane(tid >> 6);
        { const int s = tid >> 3, c8 = (tid & 7) * 8, tok = dir ? (Ls - 1 - 64 * ci - s) : (64 * ci + s), ch = h * 64 + c8;
          float xr[8], xk[8], xv[8]; shift8(a, rb, Ls, tok, ch, xr); asm volatile("" ::: "memory"); shift8(a, rb, Ls, tok, 2048 + ch, xk); asm volatile("" ::: "memory"); shift8(a, rb, Ls, tok, 4096 + ch, xv); asm volatile("" ::: "memory");
          float kk[8], ss = 0.f;
#pragma unroll
          for (int i = 0; i < 8; ++i) { kk[i] = xk[i] * a.k_k[ch + i]; ss += kk[i] * kk[i]; }
          ss += shx<1>(ss); ss += shx<2>(ss); ss += shx<4>(ss);
          const float inv = 1.f / fmaxf(sqrtf(ss), 1e-12f);
#pragma unroll
          for (int i = 0; i < 8; ++i) { Rs[s * 64 + c8 + i] = xr[i]; Vs[s * 64 + c8 + i] = xv[i]; KDs[s * 64 + c8 + i] = xk[i]; KKs[s * 64 + c8 + i] = kk[i] * inv; } }
        asm volatile("" ::: "memory");
        { const int s = tid >> 3, c16 = (tid & 7) * 16, tok = dir ? (Ls - 1 - 64 * ci - s) : (64 * ci + s);
#pragma unroll
          for (int hf = 0; hf < 2; ++hf) { asm volatile("" ::: "memory"); float xw[8], xa[8]; shift8(a, rb, Ls, tok, 6144 + dir * 128 + c16 + hf * 8, xw); asm volatile("" ::: "memory"); shift8(a, rb, Ls, tok, 6400 + dir * 128 + c16 + hf * 8, xa);
#pragma unroll
              for (int i = 0; i < 8; ++i) { TW[s * TWS + c16 + hf * 8 + i] = (bf16)f2bf(tanhf(xw[i])); PA[s * TWS + c16 + hf * 8 + i] = (bf16)f2bf(xa[i]); } } }
        __syncthreads();
        { const int tm = wid >> 1, fr = lane & 15, fq = lane >> 4;
#pragma unroll
          for (int tt = 0; tt < 2; ++tt) { const int tn = (wid & 1) * 2 + tt; f32x4 aw = (f32x4){0.f, 0.f, 0.f, 0.f}, aa = (f32x4){0.f, 0.f, 0.f, 0.f};
              const bf16* bw = a.LT + ((size_t)(0 * 2 + dir) * 2048 + h * 64 + tn * 16 + fr) * 128 + fq * 8;
              const bf16* ba = a.LT + ((size_t)(1 * 2 + dir) * 2048 + h * 64 + tn * 16 + fr) * 128 + fq * 8;
#pragma unroll
              for (int ks = 0; ks < 4; ++ks) {
                  const bf16x8 fa_w = *(const LAS bf16x8*)(TW + (tm * 16 + fr) * TWS + ks * 32 + fq * 8), fa_a = *(const LAS bf16x8*)(PA + (tm * 16 + fr) * TWS + ks * 32 + fq * 8);
                  const bf16x8 fb_w = *(const bf16x8*)(bw + ks * 32), fb_a = *(const bf16x8*)(ba + ks * 32);
                  aw = __builtin_amdgcn_mfma_f32_16x16x32_bf16(fa_w, fb_w, aw, 0, 0, 0);
                  aa = __builtin_amdgcn_mfma_f32_16x16x32_bf16(fa_a, fb_a, aa, 0, 0, 0); }
              const int n = tn * 16 + fr, chn = h * 64 + n; const float w0v = a.w0[dir * 2048 + chn], a0v = a.a0[dir * 2048 + chn], kav = a.k_a[chn];
#pragma unroll
              for (int i = 0; i < 4; ++i) { const int s = tm * 16 + fq * 4 + i; const float wl = w0v + aw[i], al = a0v + aa[i];
                  const float sp = (-wl > 20.f) ? -wl : log1pf(__expf(-wl));
                  const float dec = __expf(-__expf(-sp - 0.5f)); const float av = 1.f / (1.f + __expf(-al));
                  const float kraw = KDs[s * 64 + n], kkv = KKs[s * 64 + n];
                  Wd[s * 64 + n] = dec; KDs[s * 64 + n] = kraw * (1.f + (av - 1.f) * kav); Bs[s * 64 + n] = kkv * av; } } }
        __syncthreads();
        { const int s = tid >> 3, c8 = (tid & 7) * 8, tok = dir ? (Ls - 1 - 64 * ci - s) : (64 * ci + s); float bs = 0.f;
#pragma unroll
          for (int i = 0; i < 8; ++i) bs += Rs[s * 64 + c8 + i] * KDs[s * 64 + c8 + i] * a.r_k[h * 64 + c8 + i];
          bs += shx<1>(bs); bs += shx<2>(bs); bs += shx<4>(bs);
          if ((tid & 7) == 0) a.BON[((size_t)dir * NTOK + rb + tok) * 32 + h] = bs; }
        if (wid == 0) {
            for (int s = 0; s < 64; ++s) { const int tok = dir ? (Ls - 1 - 64 * ci - s) : (64 * ci + s);
                const LAS float *kkp = KKs + s * 64, *wp = Wd + s * 64, *bp = Bs + s * 64, *kdp = KDs + s * 64, *rp = Rs + s * 64; const float vi = Vs[s * 64 + lane];
                float sa0 = 0.f, sa1 = 0.f;
#pragma unroll
                for (int jb = 0; jb < 64; jb += 8) { const f32x4 k0 = *(const LAS f32x4*)(kkp + jb), k1 = *(const LAS f32x4*)(kkp + jb + 4);
                    sa0 += st[jb] * k0[0]; sa1 += st[jb + 1] * k0[1]; sa0 += st[jb + 2] * k0[2]; sa1 += st[jb + 3] * k0[3];
                    sa0 += st[jb + 4] * k1[0]; sa1 += st[jb + 5] * k1[1]; sa0 += st[jb + 6] * k1[2]; sa1 += st[jb + 7] * k1[3];
                    asm volatile("" ::: "memory"); }
                const float sa = -(sa0 + sa1); float y0 = 0.f, y1 = 0.f;
#pragma unroll
                for (int jb = 0; jb < 64; jb += 4) { const f32x4 w4 = *(const LAS f32x4*)(wp + jb), b4 = *(const LAS f32x4*)(bp + jb), d4 = *(const LAS f32x4*)(kdp + jb), r4 = *(const LAS f32x4*)(rp + jb);
#pragma unroll
                    for (int q = 0; q < 4; ++q) { st[jb + q] = st[jb + q] * w4[q] + sa * b4[q] + vi * d4[q]; }
                    y0 += st[jb] * r4[0]; y1 += st[jb + 1] * r4[1]; y0 += st[jb + 2] * r4[2]; y1 += st[jb + 3] * r4[3];
                    asm volatile("" ::: "memory"); }
                a.YD[((size_t)dir * NTOK + rb + tok) * 2048 + h * 64 + lane] = y0 + y1; }
        }
        __syncthreads();
    }
}
__device__ __forceinline__ float fsum16(float v) {
    v += __builtin_bit_cast(float, __builtin_amdgcn_update_dpp(0, __builtin_bit_cast(int, v), 0xB1, 0xf, 0xf, false)); v += __builtin_bit_cast(float, __builtin_amdgcn_update_dpp(0, __builtin_bit_cast(int, v), 0x4E, 0xf, 0xf, false));
    v += __builtin_bit_cast(float, __builtin_amdgcn_update_dpp(0, __builtin_bit_cast(int, v), 0x141, 0xf, 0xf, false)); v += __builtin_bit_cast(float, __builtin_amdgcn_update_dpp(0, __builtin_bit_cast(int, v), 0x140, 0xf, 0xf, false)); return v; }
__device__ __forceinline__ void finalize(Frame& F, const P& a, const float* lnx_g, const float* lnx_b, bf16* YB) {
    const int gw = F.vcu * NWAVES + F.wave, NGW = F.G * NWAVES, lane = F.lane;
    LAS float* PRM = (LAS float*)F.lds;
    for (int i = F.tid; i < 2048; i += NWAVES * 64) { PRM[i] = a.mu_prev[4096 + i]; PRM[2048 + i] = a.mu_next[4096 + i]; PRM[4096 + i] = lnx_g[i]; PRM[6144 + i] = lnx_b[i]; }
    __syncthreads();
    for (int row = gw; row < NTOK; row += NGW) { const int seqrow = row < 4 * SEQP ? (row & (SEQP - 1)) : (row - 4 * SEQP), Ls = row < 4 * SEQP ? SEQP : SEQS;
        const bool okp = seqrow > 0, okn = seqrow < Ls - 1; const int rowp = okp ? row - 1 : row, rown = okn ? row + 1 : row;
#pragma unroll 1
        for (int hb = 0; hb < 2; ++hb) {
        uint2 yf[4], yb[4]; uint2 pc[4], pp[4], pn[4]; float bon[4];
#pragma unroll
        for (int it = 0; it < 4; ++it) { const int c = (hb * 4 + it) * 256 + lane * 4, h = c >> 6;
            yf[it] = *(const uint2*)((const bf16*)a.YD + (size_t)row * 2048 + c); yb[it] = *(const uint2*)((const bf16*)a.YD + ((size_t)NTOK + row) * 2048 + c);
            pc[it] = *(const uint2*)(a.SL + (size_t)row * CSH + 4096 + c); pp[it] = *(const uint2*)(a.SL + (size_t)rowp * CSH + 4096 + c); pn[it] = *(const uint2*)(a.SL + (size_t)rown * CSH + 4096 + c);
            bon[it] = a.BON[(size_t)row * 32 + h] + a.BON[((size_t)NTOK + row) * 32 + h]; }
#pragma unroll
        for (int it = 0; it < 4; ++it) { const int c = (hb * 4 + it) * 256 + lane * 4;
            f32x4 y = (f32x4){pg8::bflo(yf[it].x) + pg8::bflo(yb[it].x), pg8::bfhi(yf[it].x) + pg8::bfhi(yb[it].x), pg8::bflo(yf[it].y) + pg8::bflo(yb[it].y), pg8::bfhi(yf[it].y) + pg8::bfhi(yb[it].y)}; float s = (y.x + y.y) + (y.z + y.w);
            s = fsum16(s);
            const float mu = s * (1.f / 64.f); y = y - mu; float q = (y.x * y.x + y.y * y.y) + (y.z * y.z + y.w * y.w);
            q = fsum16(q);
            const float rs = 1.f / sqrtf(q * (1.f / 64.f) + 64e-5f);
            const uint2 ppv = okp ? pp[it] : make_uint2(0u, 0u), pnv = okn ? pn[it] : make_uint2(0u, 0u);
            const f32x4 mp = *(const LAS f32x4*)(PRM + c), mn = *(const LAS f32x4*)(PRM + 2048 + c), g = *(const LAS f32x4*)(PRM + 4096 + c), b = *(const LAS f32x4*)(PRM + 6144 + c);
            const float c0 = pg8::bflo(pc[it].x), c1 = pg8::bfhi(pc[it].x), c2 = pg8::bflo(pc[it].y), c3 = pg8::bfhi(pc[it].y);
            const float v0 = c0 + mp.x * (pg8::bflo(ppv.x) - c0) + mn.x * (pg8::bflo(pnv.x) - c0), v1 = c1 + mp.y * (pg8::bfhi(ppv.x) - c1) + mn.y * (pg8::bfhi(pnv.x) - c1);
            const float v2 = c2 + mp.z * (pg8::bflo(ppv.y) - c2) + mn.z * (pg8::bflo(pnv.y) - c2), v3 = c3 + mp.w * (pg8::bfhi(ppv.y) - c3) + mn.w * (pg8::bfhi(pnv.y) - c3);
            uint2 o; o.x = pk2(y.x * rs * g.x + b.x + bon[it] * v0, y.y * rs * g.y + b.y + bon[it] * v1); o.y = pk2(y.z * rs * g.z + b.z + bon[it] * v2, y.w * rs * g.w + b.w + bon[it] * v3);
            *(uint2*)(YB + (size_t)row * 2048 + c) = o; } }
    }
    __syncthreads();
}
}
namespace scan2 {
constexpr int LDJ = 72, LDT = 40;
constexpr int O_KKT = 0, O_RT = 4608, O_KB = 9216, O_BB = 13824, O_VB = 18432, O_TW = 23040, O_PA = 31744, TWS = 136;
constexpr int O_RF = 40448, O_KDF = 48640, O_KKF = 56832, O_BF = 65024, O_LW = 73216;
constexpr int O_MAK = 81408, O_MRK = 83968, O_MRB = 86528, O_NB = 89088, O_NF = 91648, O_TM = 95872, O_PB = 98432, O_RHST = 100992, O_SAT = 106112, O_SC = 111232, O_GL = 120448, O_END = 120704;
static_assert(O_END <= RING_BYTES, "scan2 LDS map");
typedef unsigned u32x2 __attribute__((ext_vector_type(2)));
typedef short s16x4 __attribute__((ext_vector_type(4)));
typedef short v4i16_t __attribute__((ext_vector_type(4)));
using scan1::P; using scan1::ld8;
__device__ __forceinline__ void ld4(const bf16* p, bool ok, float (&v)[4]) { const uint2 w = ok ? *(const uint2*)p : make_uint2(0u, 0u); v[0] = pg8::bflo(w.x); v[1] = pg8::bfhi(w.x); v[2] = pg8::bflo(w.y); v[3] = pg8::bfhi(w.y); }
__device__ __forceinline__ void shift4(const P& a, int rb, int Ls, int tok, int col, float (&x)[4]) {
    const bf16* rp = a.SL + (size_t)(rb + tok) * CSH + col; float pc[4], pp[4], pn[4];
    ld4(rp, true, pc); ld4(rp - CSH, tok > 0, pp); ld4(rp + CSH, tok < Ls - 1, pn);
    const f32x4 m0 = *(const f32x4*)(a.mu_prev + col), n0 = *(const f32x4*)(a.mu_next + col);
#pragma unroll
    for (int i = 0; i < 4; ++i) x[i] = pc[i] + m0[i] * (pp[i] - pc[i]) + n0[i] * (pn[i] - pc[i]);
}
__device__ __forceinline__ bf16x8 rowfrag(const LAS unsigned char* base, int ldb, int x0, int k0, int lane) {
    return *(const LAS bf16x8*)(base + (x0 + (lane & 15)) * ldb + (k0 + 8 * (lane >> 4)) * 2);
}
__device__ __forceinline__ bf16x8 trfrag(const LAS unsigned char* base, int ldb, int x0, int k0, int lane) {
    const LAS unsigned char* p = base + (k0 + 8 * (lane >> 4) + ((lane & 15) >> 2)) * ldb + (x0 + 4 * (lane & 3)) * 2;
    const s16x4 lo = __builtin_bit_cast(s16x4, __builtin_amdgcn_ds_read_tr16_b64_v4i16((LAS v4i16_t*)p));
    const s16x4 hi = __builtin_bit_cast(s16x4, __builtin_amdgcn_ds_read_tr16_b64_v4i16((LAS v4i16_t*)(p + 4 * ldb)));
    return (bf16x8){lo[0], lo[1], lo[2], lo[3], hi[0], hi[1], hi[2], hi[3]};
}
#define MF16(a, b, c) __builtin_amdgcn_mfma_f32_16x16x32_bf16((a), (b), (c), 0, 0, 0)
__device__ __forceinline__ void store_ct(LAS unsigned char* base, int ldb, int n0, int m0, int lane, f32x4 c) {
    u32x2 w; w.x = pg8::cvt_pk_bf16(c[0], c[1]); w.y = pg8::cvt_pk_bf16(c[2], c[3]);
    *(LAS u32x2*)(base + (n0 + (lane & 15)) * ldb + (m0 + 4 * (lane >> 4)) * 2) = w;
}
constexpr int O_MU = O_END, O_TOT = O_MU + 2 * 192 * 4, O_BP = O_TOT + 8 * 64 * 4, O_END2 = O_BP + 4 * 32 * 4;
static_assert(O_END2 <= RING_BYTES, "scan2 LDS map");
struct Raw { u32x2 rkv[3][3]; u32x4 pw, pa; };
__device__ __forceinline__ void load_raw(Raw& R, const P& a, const bf16* LIN, int rb, int Ls, int tok, int h, int dir, int c4, int c8) {
    const bf16* rp = a.SL + (size_t)(rb + tok) * CSH; const bool okp = tok > 0, okn = tok < Ls - 1;
#pragma unroll
    for (int g = 0; g < 3; ++g) { const bf16* p = rp + g * 2048 + h * 64 + c4;
        R.rkv[g][1] = *(const u32x2*)p; R.rkv[g][0] = okp ? *(const u32x2*)(p - CSH) : (u32x2){0u, 0u}; R.rkv[g][2] = okn ? *(const u32x2*)(p + CSH) : (u32x2){0u, 0u}; }
    const bf16* lp = LIN + (size_t)(rb + tok) * 512 + dir * 128 + c8; R.pw = *(const u32x4*)lp; R.pa = *(const u32x4*)(lp + 256);
}
__device__ __forceinline__ float sh1(unsigned pc, unsigned pp, unsigned pn, bool hi16, float mp, float mn) {
    const float c = hi16 ? pg8::bfhi(pc) : pg8::bflo(pc), p = hi16 ? pg8::bfhi(pp) : pg8::bflo(pp), n = hi16 ? pg8::bfhi(pn) : pg8::bflo(pn);
    return c + mp * (p - c) + mn * (n - c);
}
__device__ __forceinline__ bf16 tobf(float x) { return (bf16)(pg8::cvt_pk_bf16(x, 0.f) & 0xffffu); }
__device__ __forceinline__ float fast_tanh(float x) { return 1.f - 2.f * __builtin_amdgcn_rcpf(1.f + __builtin_amdgcn_exp2f(2.885390081777927f * x)); }
__device__ __forceinline__ void lora_inputs(Frame& F, const P& a, bf16* LIN) {
    for (int it = blockIdx.x * (NWAVES * 64) + F.tid; it < NTOK * 64; it += F.G * NWAVES * 64) { const int row = it >> 6, c8 = (it & 63) * 8;
        const int seqrow = row < 4 * SEQP ? (row & (SEQP - 1)) : (row - 4 * SEQP), Ls = row < 4 * SEQP ? SEQP : SEQS; float x[8];
        scan1::shift8(a, row - seqrow, Ls, seqrow, 6144 + c8, x);
        u32x4 w;
        if (c8 < 256) { w.x = pg8::cvt_pk_bf16(fast_tanh(x[0]), fast_tanh(x[1])); w.y = pg8::cvt_pk_bf16(fast_tanh(x[2]), fast_tanh(x[3])); w.z = pg8::cvt_pk_bf16(fast_tanh(x[4]), fast_tanh(x[5])); w.w = pg8::cvt_pk_bf16(fast_tanh(x[6]), fast_tanh(x[7])); }
        else { w.x = pg8::cvt_pk_bf16(x[0], x[1]); w.y = pg8::cvt_pk_bf16(x[2], x[3]); w.z = pg8::cvt_pk_bf16(x[4], x[5]); w.w = pg8::cvt_pk_bf16(x[6], x[7]); }
        *(u32x4*)(LIN + (size_t)row * 512 + c8) = w; }
}
__device__ __forceinline__ void scan_item(Frame& F, const P& a, const bf16* LIN, int seq, int h, int dir) {
    const int rb = seq < 4 ? seq * SEQP : 4 * SEQP, Ls = seq < 4 ? SEQP : SEQS, nch = Ls / 32;
    LAS unsigned char* lds = F.lds;
    int tid0 = F.tid; asm volatile("" : "+v"(tid0));
    for (int i = tid0; i < (O_SC + 9216 - O_TM) / 4; i += NWAVES * 64) { const int o = O_TM + 4 * i; if (o < O_RHST || o >= O_SC) *(LAS unsigned*)(lds + o) = 0u; }
    if (tid0 < 192) { const int col = (tid0 >> 6) * 2048 + h * 64 + (tid0 & 63); *((LAS float*)(lds + O_MU) + tid0) = a.mu_prev[col]; *((LAS float*)(lds + O_MU) + 192 + tid0) = a.mu_next[col]; }
    f32x4 st0 = (f32x4){0.f, 0.f, 0.f, 0.f}, st1 = (f32x4){0.f, 0.f, 0.f, 0.f};
    bf16x8 fbw[4], fba[4]; float w0v, a0v, kav, rkv; f32x4 kkw;
    { const int lane = tid0 & 63, wid = __builtin_amdgcn_readfirstlane(tid0 >> 6), fr = lane & 15, fq = lane >> 4, tn = wid & 3;
      const bf16* bw = a.LT + ((size_t)(0 * 2 + dir) * 2048 + h * 64 + tn * 16 + fr) * 128 + fq * 8;
      const bf16* ba = a.LT + ((size_t)(1 * 2 + dir) * 2048 + h * 64 + tn * 16 + fr) * 128 + fq * 8;
#pragma unroll
      for (int ks = 0; ks < 4; ++ks) { fbw[ks] = *(const bf16x8*)(bw + ks * 32); fba[ks] = *(const bf16x8*)(ba + ks * 32); }
      const int chn = h * 64 + tn * 16 + fr; w0v = a.w0[dir * 2048 + chn]; a0v = a.a0[dir * 2048 + chn]; kav = a.k_a[chn]; rkv = a.r_k[chn];
      kkw = *(const f32x4*)(a.k_k + h * 64 + (tid0 & 15) * 4); }
    Raw R;
    { const int t = tid0 >> 4; load_raw(R, a, LIN, rb, Ls, dir ? (Ls - 1 - t) : t, h, dir, (tid0 & 15) * 4, (tid0 & 15) * 8); }
    __syncthreads();
    for (int ci = 0; ci < nch; ++ci) {
        int tid = tid0; asm volatile("" : "+v"(tid));
        const int lane = tid & 63, wid = __builtin_amdgcn_readfirstlane(tid >> 6), fr = lane & 15, fq = lane >> 4;
        const int tbase = dir ? (Ls - 1 - 32 * ci) : 32 * ci, tsgn = dir ? -1 : 1;
        const int tm = wid >> 2, tn = wid & 3;
        { const int t = tid >> 4, c4 = (tid & 15) * 4, c8 = (tid & 15) * 8; const LAS float* MUP = (const LAS float*)(lds + O_MU); const LAS float* MUN = MUP + 192;
          float x[3][4];
#pragma unroll
          for (int g = 0; g < 3; ++g) { const f32x4 mp = *(const LAS f32x4*)(MUP + g * 64 + c4), mn = *(const LAS f32x4*)(MUN + g * 64 + c4);
              x[g][0] = sh1(R.rkv[g][1].x, R.rkv[g][0].x, R.rkv[g][2].x, false, mp[0], mn[0]); x[g][1] = sh1(R.rkv[g][1].x, R.rkv[g][0].x, R.rkv[g][2].x, true, mp[1], mn[1]);
              x[g][2] = sh1(R.rkv[g][1].y, R.rkv[g][0].y, R.rkv[g][2].y, false, mp[2], mn[2]); x[g][3] = sh1(R.rkv[g][1].y, R.rkv[g][0].y, R.rkv[g][2].y, true, mp[3], mn[3]); }
          float kk[4], ss = 0.f;
#pragma unroll
          for (int i = 0; i < 4; ++i) { kk[i] = x[1][i] * kkw[i]; ss += kk[i] * kk[i]; }
          ss += shx<1>(ss); ss += shx<2>(ss); ss += shx<4>(ss); ss += shx<8>(ss);
          const float inv = __builtin_amdgcn_rsqf(fmaxf(ss, 1e-24f));
          *(LAS f32x4*)(lds + O_RF + (t * 64 + c4) * 4) = (f32x4){x[0][0], x[0][1], x[0][2], x[0][3]};
          *(LAS f32x4*)(lds + O_KDF + (t * 64 + c4) * 4) = (f32x4){x[1][0], x[1][1], x[1][2], x[1][3]};
          *(LAS f32x4*)(lds + O_KKF + (t * 64 + c4) * 4) = (f32x4){kk[0] * inv, kk[1] * inv, kk[2] * inv, kk[3] * inv};
          u32x2 vw; vw.x = pg8::cvt_pk_bf16(x[2][0], x[2][1]); vw.y = pg8::cvt_pk_bf16(x[2][2], x[2][3]); *(LAS u32x2*)(lds + O_VB + (t * LDJ + c4) * 2) = vw;
          *(LAS u32x4*)(lds + O_TW + (t * TWS + c8) * 2) = R.pw; *(LAS u32x4*)(lds + O_PA + (t * TWS + c8) * 2) = R.pa;
          if (ci + 1 < nch) load_raw(R, a, LIN, rb, Ls, tbase + tsgn * (32 + t), h, dir, c4, c8); }
        __syncthreads();
        const int n = tn * 16 + fr; float lw[4], av[4];
        { f32x4 aw = (f32x4){0.f, 0.f, 0.f, 0.f}, aa = aw;
#pragma unroll
          for (int ks = 0; ks < 4; ++ks) {
              aw = MF16(rowfrag(lds + O_TW, TWS * 2, tm * 16, ks * 32, lane), fbw[ks], aw);
              aa = MF16(rowfrag(lds + O_PA, TWS * 2, tm * 16, ks * 32, lane), fba[ks], aa); }
#pragma unroll
          for (int i = 0; i < 4; ++i) { lw[i] = -0.6065306597126334f * __builtin_amdgcn_rcpf(1.f + __builtin_amdgcn_exp2f(-1.4426950408889634f * (w0v + aw[i])));
              av[i] = __builtin_amdgcn_rcpf(1.f + __builtin_amdgcn_exp2f(-1.4426950408889634f * (a0v + aa[i]))); }
          lw[1] += lw[0]; lw[2] += lw[1]; lw[3] += lw[2];
          *((LAS float*)(lds + O_TOT) + (tm * 4 + fq) * 64 + n) = lw[3]; }
        __syncthreads();
        { const LAS float* TOT = (const LAS float*)(lds + O_TOT); const int grp = tm * 4 + fq; float off = 0.f;
#pragma unroll
          for (int g = 0; g < 7; ++g) { const float v = TOT[g * 64 + n]; off += (g < grp) ? v : 0.f; }
          float bs[4];
#pragma unroll
          for (int i = 0; i < 4; ++i) { const int t = tm * 16 + fq * 4 + i; const float G = off + lw[i], Gm = off + (i ? lw[i - 1] : 0.f);
              const float ep = __builtin_amdgcn_exp2f(1.4426950408889634f * G), em = __builtin_amdgcn_rcpf(ep), epm = __builtin_amdgcn_exp2f(1.4426950408889634f * Gm);
              const float rv = *((const LAS float*)(lds + O_RF) + t * 64 + n), kraw = *((const LAS float*)(lds + O_KDF) + t * 64 + n), kkv = *((const LAS float*)(lds + O_KKF) + t * 64 + n);
              const float kdv = kraw * (1.f + (av[i] - 1.f) * kav), bv = kkv * av[i];
              *(LAS bf16*)(lds + O_KKT + (t * LDJ + n) * 2) = tobf(kkv * epm); *(LAS bf16*)(lds + O_RT + (t * LDJ + n) * 2) = tobf(rv * ep);
              *(LAS bf16*)(lds + O_KB + (t * LDJ + n) * 2) = tobf(kdv * em); *(LAS bf16*)(lds + O_BB + (t * LDJ + n) * 2) = tobf(bv * em);
              bs[i] = rv * kdv * rkv;
              if (i == 3 && grp == 7) *((LAS float*)(lds + O_GL) + n) = ep; }
#pragma unroll
          for (int i = 0; i < 4; ++i) bs[i] += shx<1>(bs[i]);
#pragma unroll
          for (int i = 0; i < 4; ++i) bs[i] += shx<2>(bs[i]);
#pragma unroll
          for (int i = 0; i < 4; ++i) bs[i] += shx<4>(bs[i]);
#pragma unroll
          for (int i = 0; i < 4; ++i) bs[i] += shx<8>(bs[i]);
          if (fr == 0) *(LAS f32x4*)(lds + O_BP + (tn * 32 + tm * 16 + fq * 4) * 4) = (f32x4){bs[0], bs[1], bs[2], bs[3]}; }
        __syncthreads();
        if (tid < 32) { const LAS float* BP = (const LAS float*)(lds + O_BP); a.BON[((size_t)dir * NTOK + rb + tbase + tsgn * tid) * 32 + h] = (BP[tid] + BP[32 + tid]) + (BP[64 + tid] + BP[96 + tid]); }
        { const int blk = wid >> 1, tmm = wid & 1;
          const LAS unsigned char* Ab = lds + (blk < 2 ? O_KKT : O_RT); const LAS unsigned char* Bb_ = lds + ((blk & 1) ? O_BB : O_KB);
          const bf16x8 a0 = rowfrag(Ab, LDJ * 2, tmm * 16, 0, lane), a1 = rowfrag(Ab, LDJ * 2, tmm * 16, 32, lane);
#pragma unroll
          for (int tnn = 0; tnn < 2; ++tnn) { f32x4 c = (f32x4){0.f, 0.f, 0.f, 0.f};
              c = MF16(a0, rowfrag(Bb_, LDJ * 2, tnn * 16, 0, lane), c); c = MF16(a1, rowfrag(Bb_, LDJ * 2, tnn * 16, 32, lane), c);
              const int s = tnn * 16 + fr;
#pragma unroll
              for (int i = 0; i < 4; ++i) { const int t = tmm * 16 + 4 * fq + i; const bool keep = (blk < 2) ? (s < t) : (s <= t); c[i] = keep ? c[i] : 0.f; }
              if (blk == 1) {
#pragma unroll
                  for (int i = 0; i < 4; ++i) { const int t = tmm * 16 + 4 * fq + i; *((LAS float*)(lds + O_NF) + t * 33 + s) = c[i]; *(LAS bf16*)(lds + O_NB + (t * LDT + s) * 2) = tobf(c[i]); }
              } else store_ct(lds + (blk == 0 ? O_MAK : blk == 2 ? O_MRK : O_MRB), LDT * 2, tnn * 16, tmm * 16, lane, c); } }
        __syncthreads();
        if (wid == 0) {
            const int b = (lane >> 4) & 1, c = lane & 15; const LAS float* Nf = (const LAS float*)(lds + O_NF) + (16 * b) * 33 + 16 * b; float d[16];
#pragma unroll
            for (int r = 0; r < 16; ++r) d[r] = (r == c) ? 1.f : 0.f;
#pragma unroll
            for (int u = 0; u < 15; ++u) {
#pragma unroll
                for (int r = u + 1; r < 16; ++r) d[r] -= Nf[r * 33 + u] * d[u]; }
            if (lane < 32) {
#pragma unroll
                for (int r = 0; r < 16; ++r) { *(LAS bf16*)(lds + O_TM + ((16 * b + r) * LDT + 16 * b + c) * 2) = tobf(d[r]); *(LAS bf16*)(lds + O_TM + ((16 * (1 - b) + r) * LDT + 16 * b + c) * 2) = (bf16)0; } }
            asm volatile("s_waitcnt lgkmcnt(0)" ::: "memory");
            f32x4 p = (f32x4){0.f, 0.f, 0.f, 0.f};
            p = MF16(rowfrag(lds + O_NB, LDT * 2, 16, 0, lane), trfrag(lds + O_TM, LDT * 2, 0, 0, lane), p);
#pragma unroll
            for (int i = 0; i < 4; ++i) *(LAS bf16*)(lds + O_PB + ((16 + 4 * fq + i) * LDT + fr) * 2) = tobf(p[i]);
            asm volatile("s_waitcnt lgkmcnt(0)" ::: "memory");
            f32x4 x = (f32x4){0.f, 0.f, 0.f, 0.f};
            x = MF16(rowfrag(lds + O_TM, LDT * 2, 16, 0, lane), trfrag(lds + O_PB, LDT * 2, 0, 0, lane), x);
#pragma unroll
            for (int i = 0; i < 4; ++i) *(LAS bf16*)(lds + O_TM + ((16 + 4 * fq + i) * LDT + fr) * 2) = tobf(-x[i]);
        }
        { f32x4 c = (f32x4){0.f, 0.f, 0.f, 0.f};
          c = MF16(rowfrag(lds + O_KKT, LDJ * 2, tm * 16, 0, lane), trfrag(lds + O_SC, LDJ * 2, tn * 16, 0, lane), c);
          c = MF16(rowfrag(lds + O_KKT, LDJ * 2, tm * 16, 32, lane), trfrag(lds + O_SC, LDJ * 2, tn * 16, 32, lane), c);
          c = MF16(trfrag(lds + O_MAK, LDT * 2, tm * 16, 0, lane), trfrag(lds + O_VB, LDJ * 2, tn * 16, 0, lane), c);
          store_ct(lds + O_RHST, LDT * 2, tn * 16, tm * 16, lane, c); }
        __syncthreads();
        { f32x4 c = (f32x4){0.f, 0.f, 0.f, 0.f};
          c = MF16(rowfrag(lds + O_TM, LDT * 2, tm * 16, 0, lane), rowfrag(lds + O_RHST, LDT * 2, tn * 16, 0, lane), c);
          store_ct(lds + O_SAT, LDT * 2, tn * 16, tm * 16, lane, -c); }
        __syncthreads();
        { f32x4 c = (f32x4){0.f, 0.f, 0.f, 0.f};
          c = MF16(rowfrag(lds + O_RT, LDJ * 2, tm * 16, 0, lane), trfrag(lds + O_SC, LDJ * 2, tn * 16, 0, lane), c);
          c = MF16(rowfrag(lds + O_RT, LDJ * 2, tm * 16, 32, lane), trfrag(lds + O_SC, LDJ * 2, tn * 16, 32, lane), c);
          c = MF16(trfrag(lds + O_MRK, LDT * 2, tm * 16, 0, lane), trfrag(lds + O_VB, LDJ * 2, tn * 16, 0, lane), c);
          c = MF16(trfrag(lds + O_MRB, LDT * 2, tm * 16, 0, lane), rowfrag(lds + O_SAT, LDT * 2, tn * 16, 0, lane), c);
#pragma unroll
          for (int i = 0; i < 4; ++i) a.YD[((size_t)dir * NTOK + rb + tbase + tsgn * (tm * 16 + 4 * fq + i)) * 2048 + h * 64 + tn * 16 + fr] = c[i]; }
        const int ti = wid >> 1, tj0 = 2 * (wid & 1);
        { const bf16x8 sa = rowfrag(lds + O_SAT, LDT * 2, ti * 16, 0, lane), vt = trfrag(lds + O_VB, LDJ * 2, ti * 16, 0, lane);
          st0 = MF16(sa, trfrag(lds + O_BB, LDJ * 2, tj0 * 16, 0, lane), st0); st0 = MF16(vt, trfrag(lds + O_KB, LDJ * 2, tj0 * 16, 0, lane), st0);
          st1 = MF16(sa, trfrag(lds + O_BB, LDJ * 2, tj0 * 16 + 16, 0, lane), st1); st1 = MF16(vt, trfrag(lds + O_KB, LDJ * 2, tj0 * 16 + 16, 0, lane), st1);
          const LAS float* GL = (const LAS float*)(lds + O_GL); st0 = st0 * GL[tj0 * 16 + fr]; st1 = st1 * GL[tj0 * 16 + 16 + fr]; }
        __syncthreads();
        store_ct(lds + O_SC, LDJ * 2, tj0 * 16, ti * 16, lane, st0); store_ct(lds + O_SC, LDJ * 2, tj0 * 16 + 16, ti * 16, lane, st1);
    }
    __syncthreads();
}

namespace two {
constexpr int C_KKT = 0, C_RT = 5120, C_KB = 10240, C_BB = 15360, C_VB = 20480;
constexpr int C_TW = 25088, C_PA = 33792, C_RF = 42496, C_KDF = 47104, C_KKF = 51712;
constexpr int C_MAK = 25088, C_MRK = 27648, C_MRB = 30208, C_NB = 32768, C_NF = 35328, C_TM = 39552, C_PB = 42112, C_RHST = 44672, C_SAT = 49792;
constexpr int C_SC = 56320, C_GL = 65536, C_TOT = 65792, C_BP = 67840, CHS = 68352, C_MU = 2 * CHS, C_END = C_MU + 2 * 192 * 4;
static_assert(C_KKF + 4608 <= C_SC && C_SAT + 5120 <= C_SC && C_END <= RING_BYTES, "scan3 LDS map");
template <int CTRL> __device__ __forceinline__ float dppf(float x) { return __builtin_bit_cast(float, __builtin_amdgcn_update_dpp(0, __builtin_bit_cast(int, x), CTRL, 0xf, 0xf, false)); }
__device__ __forceinline__ float rsum16(float v) { v += dppf<0xB1>(v); v += dppf<0x4E>(v); v += dppf<0x141>(v); v += dppf<0x140>(v); return v; }
__device__ __forceinline__ s16x4 tr4(const LAS unsigned char* p) { return __builtin_bit_cast(s16x4, __builtin_amdgcn_ds_read_tr16_b64_v4i16((LAS v4i16_t*)p)); }
__device__ __forceinline__ float s2f(short x) { return __builtin_bit_cast(float, (unsigned)(unsigned short)x << 16); }
template <int U> __device__ __forceinline__ float bc16(float x) { return __builtin_bit_cast(float, __builtin_amdgcn_update_dpp(0, __builtin_bit_cast(int, x), 0x150 + U, 0xf, 0xf, false)); }
template <bool ST, int MODE = 0>
__device__ __forceinline__ void scan_item2(Frame& F, const P& a, const bf16* LIN, int seq, int h) {
    const int rb = seq < 4 ? seq * SEQP : 4 * SEQP, Ls = seq < 4 ? SEQP : SEQS, nch = Ls / 32;
    LAS unsigned char* lds = F.lds;
    int tid0 = F.tid; asm volatile("" : "+v"(tid0));
    for (int i = tid0; i < 2 * 9216 / 4; i += NWAVES * 64) { const int c = i / 2304, o = (i % 2304) * 4; *(LAS unsigned*)(lds + c * CHS + C_SC + o) = 0u; }
    if (tid0 < 192) { const int col = (tid0 >> 6) * 2048 + h * 64 + (tid0 & 63); *((LAS float*)(lds + C_MU) + tid0) = a.mu_prev[col]; *((LAS float*)(lds + C_MU) + 192 + tid0) = a.mu_next[col]; }
    f32x4 st0[2], st1[2]; bf16x8 fbw[4], fba[4]; float w0v, a0v, kav, rkv; f32x4 kkw; Raw R[2];
    { const int lane = tid0 & 63, wid = __builtin_amdgcn_readfirstlane(tid0 >> 6), fr = lane & 15, fq = lane >> 4, tn = wid & 3;
      const int chn = h * 64 + tn * 16 + fr, wc = wid >> 2; kav = a.k_a[chn]; rkv = a.r_k[chn]; kkw = *(const f32x4*)(a.k_k + h * 64 + (tid0 & 15) * 4);
      { const bf16* bw = a.LT + ((size_t)(0 * 2 + wc) * 2048 + chn) * 128 + fq * 8; const bf16* ba = a.LT + ((size_t)(1 * 2 + wc) * 2048 + chn) * 128 + fq * 8;
#pragma unroll
        for (int ks = 0; ks < 4; ++ks) { fbw[ks] = *(const bf16x8*)(bw + ks * 32); fba[ks] = *(const bf16x8*)(ba + ks * 32); }
        w0v = a.w0[wc * 2048 + chn]; a0v = a.a0[wc * 2048 + chn]; }
#pragma unroll
      for (int c = 0; c < 2; ++c) { st0[c] = (f32x4){0.f, 0.f, 0.f, 0.f}; st1[c] = st0[c];
          const int t = tid0 >> 4; load_raw(R[c], a, LIN, rb, Ls, c ? (Ls - 1 - t) : t, h, c, (tid0 & 15) * 4, (tid0 & 15) * 8); } }
    __syncthreads();
    for (int ci = 0; ci < nch; ++ci) {
        int tid = tid0; asm volatile("" : "+v"(tid));
        const int lane = tid & 63, wid = __builtin_amdgcn_readfirstlane(tid >> 6), fr = lane & 15, fq = lane >> 4, tm = wid >> 2, tn = wid & 3, n = tn * 16 + fr;
        f32x4 mpv[3], mnv[3];
        { const int c4_ = (tid & 15) * 4; const LAS float* MUP_ = (const LAS float*)(lds + C_MU);
#pragma unroll
          for (int g = 0; g < 3; ++g) { mpv[g] = *(const LAS f32x4*)(MUP_ + g * 64 + c4_); mnv[g] = *(const LAS f32x4*)(MUP_ + 192 + g * 64 + c4_); } }
        if (!(MODE & 4))
#pragma unroll
        for (int c = 0; c < 2; ++c) { LAS unsigned char* cb = lds + c * CHS; const int tbase = c ? (Ls - 1 - 32 * ci) : 32 * ci, tsgn = c ? -1 : 1;
          const int t = tid >> 4, c4 = (tid & 15) * 4, c8 = (tid & 15) * 8; const LAS float* MUP = (const LAS float*)(lds + C_MU); const LAS float* MUN = MUP + 192;
          float x[3][4];
#pragma unroll
          for (int g = 0; g < 3; ++g) { const f32x4 mp = mpv[g], mn = mnv[g];
              x[g][0] = sh1(R[c].rkv[g][1].x, R[c].rkv[g][0].x, R[c].rkv[g][2].x, false, mp[0], mn[0]); x[g][1] = sh1(R[c].rkv[g][1].x, R[c].rkv[g][0].x, R[c].rkv[g][2].x, true, mp[1], mn[1]);
              x[g][2] = sh1(R[c].rkv[g][1].y, R[c].rkv[g][0].y, R[c].rkv[g][2].y, false, mp[2], mn[2]); x[g][3] = sh1(R[c].rkv[g][1].y, R[c].rkv[g][0].y, R[c].rkv[g][2].y, true, mp[3], mn[3]); }
          float kk[4], ss = 0.f;
#pragma unroll
          for (int i = 0; i < 4; ++i) { kk[i] = x[1][i] * kkw[i]; ss += kk[i] * kk[i]; }
          ss = rsum16(ss);
          const float inv = __builtin_amdgcn_rsqf(fmaxf(ss, 1e-24f));
          u32x2 w; w.x = pg8::cvt_pk_bf16(x[0][0], x[0][1]); w.y = pg8::cvt_pk_bf16(x[0][2], x[0][3]); *(LAS u32x2*)(cb + C_RF + (t * LDJ + c4) * 2) = w;
          w.x = pg8::cvt_pk_bf16(x[1][0], x[1][1]); w.y = pg8::cvt_pk_bf16(x[1][2], x[1][3]); *(LAS u32x2*)(cb + C_KDF + (t * LDJ + c4) * 2) = w;
          w.x = pg8::cvt_pk_bf16(kk[0] * inv, kk[1] * inv); w.y = pg8::cvt_pk_bf16(kk[2] * inv, kk[3] * inv); *(LAS u32x2*)(cb + C_KKF + (t * LDJ + c4) * 2) = w;
          w.x = pg8::cvt_pk_bf16(x[2][0], x[2][1]); w.y = pg8::cvt_pk_bf16(x[2][2], x[2][3]); *(LAS u32x2*)(cb + C_VB + (t * LDJ + c4) * 2) = w;
          *(LAS u32x4*)(cb + C_TW + (t * TWS + c8) * 2) = R[c].pw; *(LAS u32x4*)(cb + C_PA + (t * TWS + c8) * 2) = R[c].pa;
          if (!(MODE & 1) && ci + 1 < nch) load_raw(R[c], a, LIN, rb, Ls, tbase + tsgn * (32 + t), h, c, c4, c8); }
        __syncthreads();
        if (!(MODE & 24)) { const int wc = wid >> 2; LAS unsigned char* cb = lds + wc * CHS;
          bf16x8 f2[2][8]; s16x4 rr2[2], kr2[2], kkr2[2];
#pragma unroll
          for (int tq = 0; tq < 2; ++tq) {
#pragma unroll
            for (int ks = 0; ks < 4; ++ks) { f2[tq][ks] = rowfrag(cb + C_TW, TWS * 2, tq * 16, ks * 32, lane); f2[tq][4 + ks] = rowfrag(cb + C_PA, TWS * 2, tq * 16, ks * 32, lane); } }
#pragma unroll
          for (int tq = 0; tq < 2; ++tq) { const LAS unsigned char* trp = cb + ((tq * 16 + 4 * fq + (fr >> 2)) * LDJ + tn * 16 + (fr & 3) * 4) * 2;
            rr2[tq] = tr4(trp + C_RF); kr2[tq] = tr4(trp + C_KDF); kkr2[tq] = tr4(trp + C_KKF); }
          __builtin_amdgcn_sched_barrier(0);
          float lw[2][4], av[2][4];
#pragma unroll
          for (int tq = 0; tq < 2; ++tq) { f32x4 aw = (f32x4){0.f, 0.f, 0.f, 0.f}, aa = aw;
#pragma unroll
            for (int ks = 0; ks < 4; ++ks) { aw = MF16(f2[tq][ks], fbw[ks], aw); aa = MF16(f2[tq][4 + ks], fba[ks], aa); }
#pragma unroll
            for (int i = 0; i < 4; ++i) { lw[tq][i] = -0.6065306597126334f * __builtin_amdgcn_rcpf(1.f + __builtin_amdgcn_exp2f(-1.4426950408889634f * (w0v + aw[i])));
                av[tq][i] = __builtin_amdgcn_rcpf(1.f + __builtin_amdgcn_exp2f(-1.4426950408889634f * (a0v + aa[i]))); }
            lw[tq][1] += lw[tq][0]; lw[tq][2] += lw[tq][1]; lw[tq][3] += lw[tq][2]; }
          float off[2];
          { const float t0 = lw[0][3], t1 = lw[1][3], x0 = shx<16>(t0), x1 = shx<16>(t1), p0 = t0 + x0, p1 = t1 + x1, y0 = shx<32>(p0), y1 = shx<32>(p1);
            off[0] = ((fq & 1) ? x0 : 0.f) + ((fq & 2) ? y0 : 0.f); off[1] = (p0 + y0) + ((fq & 1) ? x1 : 0.f) + ((fq & 2) ? y1 : 0.f); }
#pragma unroll
          for (int tq = 0; tq < 2; ++tq) { const s16x4 rr = rr2[tq], kr = kr2[tq], kkr = kkr2[tq];
            float bs[4]; f32x4 okk, ort, okb, obb; float epm = __builtin_amdgcn_exp2f(1.4426950408889634f * off[tq]);
#pragma unroll
            for (int i = 0; i < 4; ++i) { const float G = off[tq] + lw[tq][i];
                const float ep = __builtin_amdgcn_exp2f(1.4426950408889634f * G), em = __builtin_amdgcn_rcpf(ep);
                const float rv = s2f(rr[i]), kraw = s2f(kr[i]), kkv = s2f(kkr[i]);
                const float kdv = kraw * (1.f + (av[tq][i] - 1.f) * kav), bv = kkv * av[tq][i];
                okk[i] = kkv * epm; ort[i] = rv * ep; okb[i] = kdv * em; obb[i] = bv * em;
                bs[i] = rv * kdv * rkv; epm = ep;
                if (i == 3 && tq == 1 && fq == 3) *((LAS float*)(cb + C_GL) + n) = ep; }
            store_ct(cb + C_KKT, LDT * 2, tn * 16, tq * 16, lane, okk); store_ct(cb + C_RT, LDT * 2, tn * 16, tq * 16, lane, ort);
            store_ct(cb + C_KB, LDT * 2, tn * 16, tq * 16, lane, okb); store_ct(cb + C_BB, LDT * 2, tn * 16, tq * 16, lane, obb);
#pragma unroll
            for (int i = 0; i < 4; ++i) bs[i] = rsum16(bs[i]);
            if (fr == 0) *(LAS f32x4*)(cb + C_BP + (tn * 32 + tq * 16 + fq * 4) * 4) = (f32x4){bs[0], bs[1], bs[2], bs[3]}; } }
        __syncthreads();
        if (!(MODE & 32)) {
        if (tid < 64) { const int c = tid >> 5, t = tid & 31; const LAS float* BP = (const LAS float*)(lds + c * CHS + C_BP); const int tok = c ? (Ls - 1 - 32 * ci - t) : (32 * ci + t);
            if (ST) a.BON[((size_t)c * NTOK + rb + tok) * 32 + h] = (BP[t] + BP[32 + t]) + (BP[64 + t] + BP[96 + t]); }
        if (tid >= 64 && tid < 64 + 160) { const int i = tid - 64, c = i / 80, o = (i % 80) * 16; *(LAS u32x4*)(lds + c * CHS + C_PB + o) = (u32x4){0u, 0u, 0u, 0u}; }
        if (tid >= 256 && tid < 384) { const int i = tid - 256, c = i >> 6, r = (i & 63) >> 1, hf = i & 1;
            *(LAS u32x4*)(lds + c * CHS + C_TM + (r * LDT + (r < 16 ? 16 : 0)) * 2 + hf * 16) = (u32x4){0u, 0u, 0u, 0u}; }
        bf16x8 f4a[2][2], f4b[2][2][2];
#pragma unroll
        for (int c = 0; c < 2; ++c) { LAS unsigned char* cb = lds + c * CHS; const int blk = wid >> 1, tmm = wid & 1;
          const LAS unsigned char* Ab = cb + (blk < 2 ? C_KKT : C_RT); const LAS unsigned char* Bb_ = cb + ((blk & 1) ? C_BB : C_KB);
          f4a[c][0] = trfrag(Ab, LDT * 2, tmm * 16, 0, lane); f4a[c][1] = trfrag(Ab, LDT * 2, tmm * 16, 32, lane);
#pragma unroll
          for (int tnn = 0; tnn < 2; ++tnn) { f4b[c][tnn][0] = trfrag(Bb_, LDT * 2, tnn * 16, 0, lane); f4b[c][tnn][1] = trfrag(Bb_, LDT * 2, tnn * 16, 32, lane); } }
        __builtin_amdgcn_sched_barrier(0);
#pragma unroll
        for (int c = 0; c < 2; ++c) { LAS unsigned char* cb = lds + c * CHS; const int blk = wid >> 1, tmm = wid & 1;
          const bf16x8 a0 = f4a[c][0], a1 = f4a[c][1]; const int lim = tmm * 16 + 4 * fq + (blk >= 2 ? 1 : 0);
#pragma unroll
          for (int tnn = 0; tnn < 2; ++tnn) { f32x4 cc = (f32x4){0.f, 0.f, 0.f, 0.f};
              cc = MF16(a0, f4b[c][tnn][0], cc); cc = MF16(a1, f4b[c][tnn][1], cc);
              const int s = tnn * 16 + fr;
#pragma unroll
              for (int i = 0; i < 4; ++i) cc[i] = (s < lim + i) ? cc[i] : 0.f;
              if (blk == 1) {
#pragma unroll
                  for (int i = 0; i < 4; ++i) { const int t = tmm * 16 + 4 * fq + i; *((LAS float*)(cb + C_NF) + t * 33 + s) = cc[i]; *(LAS bf16*)(cb + C_NB + (t * LDT + s) * 2) = tobf(cc[i]); }
              } else store_ct(cb + (blk == 0 ? C_MAK : blk == 2 ? C_MRK : C_MRB), LDT * 2, tnn * 16, tmm * 16, lane, cc); } }
        }
        __syncthreads();
        if (wid < 2 && !(MODE & 2)) { LAS unsigned char* cb = lds + wid * CHS;
#define FD(acc, n, x, U) asm volatile("v_fmac_f32_dpp %0, %1, %2 row_newbcast:" #U " row_mask:0xf bank_mask:0xf" : "+v"(acc) : "v"(n), "v"(x))
#define FD0(acc, n, x, U) asm volatile("s_nop 1\n\tv_fmac_f32_dpp %0, %1, %2 row_newbcast:" #U " row_mask:0xf bank_mask:0xf" : "+v"(acc) : "v"(n), "v"(x))
            const int b = (lane >> 4) & 1, c = lane & 15; const LAS float* Nf = (const LAS float*)(cb + C_NF) + (16 * b) * 33 + 16 * b + c; float d[16], nd[16];
            float nr[16];
#pragma unroll
            for (int r = 1; r < 16; ++r) nr[r] = Nf[r * 33];
            asm volatile("" :: "v"(nr[1]), "v"(nr[2]), "v"(nr[3]), "v"(nr[4]), "v"(nr[5]), "v"(nr[6]), "v"(nr[7]), "v"(nr[8]), "v"(nr[9]), "v"(nr[10]), "v"(nr[11]), "v"(nr[12]), "v"(nr[13]), "v"(nr[14]), "v"(nr[15]));
            d[0] = (c == 0) ? 1.f : 0.f; nd[0] = -d[0];
            { const float n_ = nr[1]; float a0 = (c == 1) ? 1.f : 0.f, a1 = 0.f; float s_ = a0 + a1; FD0(s_, n_, nd[0], 0); d[1] = s_; nd[1] = -s_; }
            { const float n_ = nr[2]; float a0 = (c == 2) ? 1.f : 0.f, a1 = 0.f; FD0(a0, n_, nd[0], 0); float s_ = a0 + a1; FD(s_, n_, nd[1], 1); d[2] = s_; nd[2] = -s_; }
            { const float n_ = nr[3]; float a0 = (c == 3) ? 1.f : 0.f, a1 = 0.f; FD0(a0, n_, nd[0], 0); FD(a1, n_, nd[1], 1); float s_ = a0 + a1; FD(s_, n_, nd[2], 2); d[3] = s_; nd[3] = -s_; }
            { const float n_ = nr[4]; float a0 = (c == 4) ? 1.f : 0.f, a1 = 0.f; FD0(a0, n_, nd[0], 0); FD(a1, n_, nd[1], 1); FD(a0, n_, nd[2], 2); float s_ = a0 + a1; FD(s_, n_, nd[3], 3); d[4] = s_; nd[4] = -s_; }
            { const float n_ = nr[5]; float a0 = (c == 5) ? 1.f : 0.f, a1 = 0.f; FD0(a0, n_, nd[0], 0); FD(a1, n_, nd[1], 1); FD(a0, n_, nd[2], 2); FD(a1, n_, nd[3], 3); float s_ = a0 + a1; FD(s_, n_, nd[4], 4); d[5] = s_; nd[5] = -s_; }
            { const float n_ = nr[6]; float a0 = (c == 6) ? 1.f : 0.f, a1 = 0.f; FD0(a0, n_, nd[0], 0); FD(a1, n_, nd[1], 1); FD(a0, n_, nd[2], 2); FD(a1, n_, nd[3], 3); FD(a0, n_, nd[4], 4); float s_ = a0 + a1; FD(s_, n_, nd[5], 5); d[6] = s_; nd[6] = -s_; }
            { const float n_ = nr[7]; float a0 = (c == 7) ? 1.f : 0.f, a1 = 0.f; FD0(a0, n_, nd[0], 0); FD(a1, n_, nd[1], 1); FD(a0, n_, nd[2], 2); FD(a1, n_, nd[3], 3); FD(a0, n_, nd[4], 4); FD(a1, n_, nd[5], 5); float s_ = a0 + a1; FD(s_, n_, nd[6], 6); d[7] = s_; nd[7] = -s_; }
            { const float n_ = nr[8]; float a0 = (c == 8) ? 1.f : 0.f, a1 = 0.f; FD0(a0, n_, nd[0], 0); FD(a1, n_, nd[1], 1); FD(a0, n_, nd[2], 2); FD(a1, n_, nd[3], 3); FD(a0, n_, nd[4], 4); FD(a1, n_, nd[5], 5); FD(a0, n_, nd[6], 6); float s_ = a0 + a1; FD(s_, n_, nd[7], 7); d[8] = s_; nd[8] = -s_; }
            { const float n_ = nr[9]; float a0 = (c == 9) ? 1.f : 0.f, a1 = 0.f; FD0(a0, n_, nd[0], 0); FD(a1, n_, nd[1], 1); FD(a0, n_, nd[2], 2); FD(a1, n_, nd[3], 3); FD(a0, n_, nd[4], 4); FD(a1, n_, nd[5], 5); FD(a0, n_, nd[6], 6); FD(a1, n_, nd[7], 7); float s_ = a0 + a1; FD(s_, n_, nd[8], 8); d[9] = s_; nd[9] = -s_; }
            { const float n_ = nr[10]; float a0 = (c == 10) ? 1.f : 0.f, a1 = 0.f; FD0(a0, n_, nd[0], 0); FD(a1, n_, nd[1], 1); FD(a0, n_, nd[2], 2); FD(a1, n_, nd[3], 3); FD(a0, n_, nd[4], 4); FD(a1, n_, nd[5], 5); FD(a0, n_, nd[6], 6); FD(a1, n_, nd[7], 7); FD(a0, n_, nd[8], 8); float s_ = a0 + a1; FD(s_, n_, nd[9], 9); d[10] = s_; nd[10] = -s_; }
            { const float n_ = nr[11]; float a0 = (c == 11) ? 1.f : 0.f, a1 = 0.f; FD0(a0, n_, nd[0], 0); FD(a1, n_, nd[1], 1); FD(a0, n_, nd[2], 2); FD(a1, n_, nd[3], 3); FD(a0, n_, nd[4], 4); FD(a1, n_, nd[5], 5); FD(a0, n_, nd[6], 6); FD(a1, n_, nd[7], 7); FD(a0, n_, nd[8], 8); FD(a1, n_, nd[9], 9); float s_ = a0 + a1; FD(s_, n_, nd[10], 10); d[11] = s_; nd[11] = -s_; }
            { const float n_ = nr[12]; float a0 = (c == 12) ? 1.f : 0.f, a1 = 0.f; FD0(a0, n_, nd[0], 0); FD(a1, n_, nd[1], 1); FD(a0, n_, nd[2], 2); FD(a1, n_, nd[3], 3); FD(a0, n_, nd[4], 4); FD(a1, n_, nd[5], 5); FD(a0, n_, nd[6], 6); FD(a1, n_, nd[7], 7); FD(a0, n_, nd[8], 8); FD(a1, n_, nd[9], 9); FD(a0, n_, nd[10], 10); float s_ = a0 + a1; FD(s_, n_, nd[11], 11); d[12] = s_; nd[12] = -s_; }
            { const float n_ = nr[13]; float a0 = (c == 13) ? 1.f : 0.f, a1 = 0.f; FD0(a0, n_, nd[0], 0); FD(a1, n_, nd[1], 1); FD(a0, n_, nd[2], 2); FD(a1, n_, nd[3], 3); FD(a0, n_, nd[4], 4); FD(a1, n_, nd[5], 5); FD(a0, n_, nd[6], 6); FD(a1, n_, nd[7], 7); FD(a0, n_, nd[8], 8); FD(a1, n_, nd[9], 9); FD(a0, n_, nd[10], 10); FD(a1, n_, nd[11], 11); float s_ = a0 + a1; FD(s_, n_, nd[12], 12); d[13] = s_; nd[13] = -s_; }
            { const float n_ = nr[14]; float a0 = (c == 14) ? 1.f : 0.f, a1 = 0.f; FD0(a0, n_, nd[0], 0); FD(a1, n_, nd[1], 1); FD(a0, n_, nd[2], 2); FD(a1, n_, nd[3], 3); FD(a0, n_, nd[4], 4); FD(a1, n_, nd[5], 5); FD(a0, n_, nd[6], 6); FD(a1, n_, nd[7], 7); FD(a0, n_, nd[8], 8); FD(a1, n_, nd[9], 9); FD(a0, n_, nd[10], 10); FD(a1, n_, nd[11], 11); FD(a0, n_, nd[12], 12); float s_ = a0 + a1; FD(s_, n_, nd[13], 13); d[14] = s_; nd[14] = -s_; }
            { const float n_ = nr[15]; float a0 = (c == 15) ? 1.f : 0.f, a1 = 0.f; FD0(a0, n_, nd[0], 0); FD(a1, n_, nd[1], 1); FD(a0, n_, nd[2], 2); FD(a1, n_, nd[3], 3); FD(a0, n_, nd[4], 4); FD(a1, n_, nd[5], 5); FD(a0, n_, nd[6], 6); FD(a1, n_, nd[7], 7); FD(a0, n_, nd[8], 8); FD(a1, n_, nd[9], 9); FD(a0, n_, nd[10], 10); FD(a1, n_, nd[11], 11); FD(a0, n_, nd[12], 12); FD(a1, n_, nd[13], 13); float s_ = a0 + a1; FD(s_, n_, nd[14], 14); d[15] = s_; nd[15] = -s_; }
#undef FD
#undef FD0
            if (lane < 32) {
#pragma unroll
                for (int r = 0; r < 16; ++r) *(LAS bf16*)(cb + C_TM + ((16 * b + r) * LDT + 16 * b + c) * 2) = tobf(d[r]); }
            asm volatile("s_waitcnt lgkmcnt(0)" ::: "memory");
            f32x4 p = (f32x4){0.f, 0.f, 0.f, 0.f};
            p = MF16(rowfrag(cb + C_NB, LDT * 2, 16, 0, lane), trfrag(cb + C_TM, LDT * 2, 0, 0, lane), p);
#pragma unroll
            for (int i = 0; i < 4; ++i) *(LAS bf16*)(cb + C_PB + ((16 + 4 * fq + i) * LDT + fr) * 2) = tobf(p[i]);
            asm volatile("s_waitcnt lgkmcnt(0)" ::: "memory");
            f32x4 x = (f32x4){0.f, 0.f, 0.f, 0.f};
            x = MF16(rowfrag(cb + C_TM, LDT * 2, 16, 0, lane), trfrag(cb + C_PB, LDT * 2, 0, 0, lane), x);
#pragma unroll
            for (int i = 0; i < 4; ++i) *(LAS bf16*)(cb + C_TM + ((16 + 4 * fq + i) * LDT + fr) * 2) = tobf(-x[i]);
        }
        if (!(MODE & 64))
        { bf16x8 f7[2][6];
#pragma unroll
          for (int c = 0; c < 2; ++c) { LAS unsigned char* cb = lds + c * CHS;
            f7[c][0] = trfrag(cb + C_KKT, LDT * 2, tm * 16, 0, lane); f7[c][1] = trfrag(cb + C_SC, LDJ * 2, tn * 16, 0, lane); f7[c][2] = trfrag(cb + C_KKT, LDT * 2, tm * 16, 32, lane); f7[c][3] = trfrag(cb + C_SC, LDJ * 2, tn * 16, 32, lane);
            f7[c][4] = trfrag(cb + C_MAK, LDT * 2, tm * 16, 0, lane); f7[c][5] = trfrag(cb + C_VB, LDJ * 2, tn * 16, 0, lane); }
          __builtin_amdgcn_sched_barrier(0);
#pragma unroll
          for (int c = 0; c < 2; ++c) { LAS unsigned char* cb = lds + c * CHS; f32x4 cc = (f32x4){0.f, 0.f, 0.f, 0.f};
            cc = MF16(f7[c][0], f7[c][1], cc); cc = MF16(f7[c][2], f7[c][3], cc); cc = MF16(f7[c][4], f7[c][5], cc);
            store_ct(cb + C_RHST, LDT * 2, tn * 16, tm * 16, lane, cc); } }
        __syncthreads();
        if (!(MODE & 128))
        { bf16x8 f8[2][2];
#pragma unroll
          for (int c = 0; c < 2; ++c) { LAS unsigned char* cb = lds + c * CHS; f8[c][0] = rowfrag(cb + C_TM, LDT * 2, tm * 16, 0, lane); f8[c][1] = rowfrag(cb + C_RHST, LDT * 2, tn * 16, 0, lane); }
          __builtin_amdgcn_sched_barrier(0);
#pragma unroll
          for (int c = 0; c < 2; ++c) { LAS unsigned char* cb = lds + c * CHS; f32x4 cc = (f32x4){0.f, 0.f, 0.f, 0.f};
            cc = MF16(f8[c][0], f8[c][1], cc);
            store_ct(cb + C_SAT, LDT * 2, tn * 16, tm * 16, lane, -cc); } }
        __syncthreads();
        const int ti = wid >> 1, tj0 = 2 * (wid & 1);
        if (!(MODE & 256))
#pragma unroll
        for (int c = 0; c < 2; ++c) { LAS unsigned char* cb = lds + c * CHS; const int tbase = c ? (Ls - 1 - 32 * ci) : 32 * ci, tsgn = c ? -1 : 1; f32x4 cc = (f32x4){0.f, 0.f, 0.f, 0.f};
          bf16x8 f9[14]; const LAS float* GL = (const LAS float*)(cb + C_GL);
          f9[0] = trfrag(cb + C_RT, LDT * 2, tm * 16, 0, lane); f9[1] = trfrag(cb + C_SC, LDJ * 2, tn * 16, 0, lane); f9[2] = trfrag(cb + C_RT, LDT * 2, tm * 16, 32, lane); f9[3] = trfrag(cb + C_SC, LDJ * 2, tn * 16, 32, lane);
          f9[4] = trfrag(cb + C_MRK, LDT * 2, tm * 16, 0, lane); f9[5] = trfrag(cb + C_VB, LDJ * 2, tn * 16, 0, lane); f9[6] = trfrag(cb + C_MRB, LDT * 2, tm * 16, 0, lane); f9[7] = rowfrag(cb + C_SAT, LDT * 2, tn * 16, 0, lane);
          f9[8] = rowfrag(cb + C_SAT, LDT * 2, ti * 16, 0, lane); f9[9] = trfrag(cb + C_VB, LDJ * 2, ti * 16, 0, lane);
          f9[10] = rowfrag(cb + C_BB, LDT * 2, tj0 * 16, 0, lane); f9[11] = rowfrag(cb + C_KB, LDT * 2, tj0 * 16, 0, lane); f9[12] = rowfrag(cb + C_BB, LDT * 2, tj0 * 16 + 16, 0, lane); f9[13] = rowfrag(cb + C_KB, LDT * 2, tj0 * 16 + 16, 0, lane);
          const float gl0 = GL[tj0 * 16 + fr], gl1 = GL[tj0 * 16 + 16 + fr];
          __builtin_amdgcn_sched_barrier(0);
          cc = MF16(f9[0], f9[1], cc); cc = MF16(f9[2], f9[3], cc); cc = MF16(f9[4], f9[5], cc); cc = MF16(f9[6], f9[7], cc);
#pragma unroll
          for (int i = 0; i < 4; ++i) { if (ST) ((bf16*)a.YD)[((size_t)c * NTOK + rb + tbase + tsgn * (tm * 16 + 4 * fq + i)) * 2048 + h * 64 + tn * 16 + fr] = tobf(cc[i]); else asm volatile("" :: "v"(cc[i])); }
          st0[c] = MF16(f9[8], f9[10], st0[c]); st0[c] = MF16(f9[9], f9[11], st0[c]);
          st1[c] = MF16(f9[8], f9[12], st1[c]); st1[c] = MF16(f9[9], f9[13], st1[c]);
          st0[c] = st0[c] * gl0; st1[c] = st1[c] * gl1; __builtin_amdgcn_sched_barrier(0); }
        __syncthreads();
#pragma unroll
        for (int c = 0; c < 2; ++c) { LAS unsigned char* cb = lds + c * CHS; store_ct(cb + C_SC, LDJ * 2, tj0 * 16, ti * 16, lane, st0[c]); store_ct(cb + C_SC, LDJ * 2, tj0 * 16 + 16, ti * 16, lane, st1[c]); }
    }
    __syncthreads();
}
}
#undef MF16
}
constexpr int NPHASE = 9;
struct Args { const float* in[24]; float* out; unsigned char* ws; int ph_lo, ph_hi; };
__global__ void __launch_bounds__(NWAVES * 64, 2) fwd_kernel(Args args) {
    extern __shared__ __attribute__((aligned(16))) unsigned char lds[];
    Frame F;
    F.lds = (LAS unsigned char*)lds;
    F.MISC = (volatile LAS unsigned*)(F.lds + MISC_OFF);
    F.tid = threadIdx.x; F.lane = F.tid & 63; F.wave = __builtin_amdgcn_readfirstlane(F.tid >> 6);
    F.G = gridDim.x; { const int bx = blockIdx.x; F.vcu = (F.G % 8 == 0) ? (bx % 8) * (F.G / 8) + bx / 8 : bx; }
    unsigned char* ws = args.ws;
    F.ctl = (gu32*)(ws + WS_CTL);
    for (int u = F.tid; u < (LDS_BYTES - MISC_OFF) / 4; u += NWAVES * 64) ((LAS unsigned*)(F.lds + MISC_OFF))[u] = 0u;
    __syncthreads();
    const int lo = args.ph_lo, hi = args.ph_hi;
    XcdBarrier bar; bar.bar = (unsigned*)(F.ctl + CW_BAR); bar.x = 0; bar.st = nullptr;
    if (hi - lo > 1) bar = xcd_barrier_post((unsigned*)(F.ctl + CW_BAR), F.MISC + 8);
#ifdef ONLYPH
#define IN(k) ((k) == ONLYPH && lo <= (k) && (k) < hi)
#else
#define IN(k) (lo <= (k) && (k) < hi)
#endif
#define SEAM(k) do { if (IN(k) && IN((k) + 1)) xcd_barrier(bar); } while (0)
    const float *x_prompt = args.in[0], *x_sample = args.in[1], *norm_g = args.in[2], *w_in = args.in[3], *mu_prev = args.in[4], *mu_next = args.in[5];
    const float *lam_q1 = args.in[6], *lam_k1 = args.in[7], *lam_q2 = args.in[8], *lam_k2 = args.in[9], *subln_g = args.in[10];
    const float *w0 = args.in[11], *w_lora = args.in[12], *a0 = args.in[13], *a_lora = args.in[14], *k_k = args.in[15], *k_a = args.in[16], *r_k = args.in[17];
    const float *lnx_g = args.in[18], *lnx_b = args.in[19], *w_oA = args.in[20], *w_oB = args.in[21], *w_out = args.in[22], *final_g = args.in[23];
    float* ROPE = (float*)(ws + WS_ROPE); bf16* LT = (bf16*)(ws + WS_LORA); float* BON = (float*)(ws + WS_BONUS); float* PART = (float*)(ws + WS_PART);
    bf16 *WOA = (bf16*)(ws + WS_WOA), *WOB = (bf16*)(ws + WS_WOB), *WOUT = (bf16*)(ws + WS_WOUT), *WIN = (bf16*)(ws + WS_WIN), *Hb = (bf16*)(ws + WS_H);
    bf16 *Qb = (bf16*)(ws + WS_Q), *Kb = (bf16*)(ws + WS_K), *Vb = (bf16*)(ws + WS_V), *SL = (bf16*)(ws + WS_SLAB), *YBb = (bf16*)(ws + WS_YB), *Mb = (bf16*)(ws + WS_M), *LIN = (bf16*)(ws + WS_LIN);
    bf16* Gb = (bf16*)args.out;
    float* YD = args.out;
    const int gw = F.vcu * NWAVES + F.wave, NGW = F.G * NWAVES;

    if (IN(0)) {
        LAS float* scr = (LAS float*)(F.lds + RING_OFF + F.wave * 16384);
        constexpr int I_IN = (DM / 64) * (NIN / 32), I_OA = (WA / 64) * (DM / 32), I_OUT = (DM / 64) * (DM / 32), I_L = (128 / 64) * (WA / 32);
        constexpr int NITEMS = I_IN + 2 * I_OA + I_OUT + 4 * I_L;
        for (int it = gw; it < NITEMS; it += NGW) {
            int r = it;
            if (r < I_IN) { p0_transpose_item(w_in, DM, NIN, WIN, scr, r, F.lane, true); continue; } r -= I_IN;
            if (r < I_OA) { p0_transpose_item(w_oA, WA, DM, WOA, scr, r, F.lane, false); continue; } r -= I_OA;
            if (r < I_OA) { p0_transpose_item(w_oB, WA, DM, WOB, scr, r, F.lane, false); continue; } r -= I_OA;
            if (r < I_OUT) { p0_transpose_item(w_out, DM, DM, WOUT, scr, r, F.lane, false); continue; } r -= I_OUT;
            const int which = r / I_L; r -= which * I_L;
            p0_transpose_item((which < 2 ? w_lora : a_lora) + (size_t)(which & 1) * 128 * WA, 128, WA, LT + (size_t)which * WA * 128, scr, r, F.lane, false);
        }
        for (int m = gw; m < NTOK; m += NGW) rms_row_to_bf16(m < 4 * SEQP ? x_prompt + (size_t)m * DM : x_sample + (size_t)(m - 4 * SEQP) * DM, norm_g, Hb + (size_t)m * DM, F.lane);
        for (int e = blockIdx.x * (NWAVES * 64) + F.tid; e < SEQS * 32; e += F.G * NWAVES * 64) { const int pos = e >> 5, i = e & 31;
            const float inv = 1.0f / powf(10000.f, (float)(2 * i) / 64.f); const float ang = (float)pos * inv; double sn, cs; sincos((double)ang, &sn, &cs);
            ROPE[2 * e] = (float)cs; ROPE[2 * e + 1] = (float)sn; }
    }
    SEAM(0);
    if (IN(1)) {
        pg8::Gemm g{Hb, WIN, NTOK, N_A, DM}; pg8::StaticOrder S; S.init(NTOK, N_A, F.G, (int)blockIdx.x);
        pg8::EpiInA E{Qb, Kb, Vb, SL, ROPE};
        pg8::gemm_phase<pg8::EpiInA, pg8::StaticOrder, true, true>(F.lds + RING_OFF, g, S, E);
    }
    SEAM(1);
    if (IN(2)) { const scan1::P sp{SL, mu_prev, mu_next, w0, a0, k_k, k_a, r_k, LT, YD, BON}; scan2::lora_inputs(F, sp, LIN); }
    SEAM(2);
    if (IN(3)) {
        { const float a = wave_sum(lam_q1[F.lane] * lam_k1[F.lane]), b = wave_sum(lam_q2[F.lane] * lam_k2[F.lane]); if (F.tid == 0) F.MISC[1] = __builtin_bit_cast(unsigned, __expf(a) - __expf(b) + 0.2f); }
        __syncthreads();
        const scan1::P sp{SL, mu_prev, mu_next, w0, a0, k_k, k_a, r_k, LT, YD, BON};
        constexpr int Q_SS = 4, Q_SP = 16, Q_AS = 256, Q_AP = 256, Q_ALL = Q_SS + Q_SP + Q_AS + Q_AP;
        const int myx = (int)(xb_xcc_id() & 7u);
        for (int kq = 0; kq < 8; ++kq) { const int qx = (myx + kq) & 7;
            for (;;) {
                __syncthreads();
                if (F.tid == 0) { F.MISC[0] = __hip_atomic_fetch_add(F.ctl + CW_QUEUE + 64 * qx, 1u, RLX_AGENT); F.MISC[2] = __hip_atomic_load(F.ctl + CW_POS + 64 * qx, RLX_AGENT); }
                __syncthreads();
                int it = (int)F.MISC[0];
                if (it >= Q_ALL) break;
                if (it < Q_SS) { scan2::two::scan_item2<true>(F, sp, LIN, 4, 4 * qx + it); continue; } it -= Q_SS;
                if (it < Q_SP) { scan2::two::scan_item2<true>(F, sp, LIN, it >> 2, 4 * qx + (it & 3)); continue; } it -= Q_SP;
                const unsigned pos = F.MISC[2];
                if (it < Q_AS) { const int hh = 2 * qx + (it >> 7); const unsigned hk = 1u + 64u + (unsigned)hh;
                    att::attn_unit(F.lds, Qb, Kb, Vb, Qb, 4 * SEQP, SEQS, hh, (it & 127) * 128, (const LAS float*)(F.lds + MISC_OFF + 4), subln_g); continue; } it -= Q_AS;
                { const int seq = it >> 6, r = it & 63, hh = 2 * qx + (r >> 5); const unsigned hk = 1u + 16u * (unsigned)seq + (unsigned)hh;
                  att::attn_unit(F.lds, Qb, Kb, Vb, Qb, seq * SEQP, SEQP, hh, (r & 31) * 128, (const LAS float*)(F.lds + MISC_OFF + 4), subln_g); }
            }
        }
    }
    SEAM(3);
    if (IN(4)) { const scan1::P sp{SL, mu_prev, mu_next, w0, a0, k_k, k_a, r_k, LT, YD, BON}; scan1::finalize(F, sp, lnx_g, lnx_b, YBb); }
    SEAM(4);
    if (IN(5)) {
        { pg8::Gemm g{Hb, WIN + (size_t)N_A * DM, NTOK, 4096, DM}; pg8::StaticOrder S; S.init(NTOK, 4096, F.G, (int)blockIdx.x);
          pg8::EpiZ E{Qb, YBb}; pg8::gemm_phase<pg8::EpiZ, pg8::StaticOrder, true, true>(F.lds + RING_OFF, g, S, E); }
        __syncthreads();
        { pg8::Gemm g{Hb, WIN + (size_t)(N_A + 4096) * DM, NTOK, 8192, DM}; pg8::StaticOrder S; S.init(NTOK, 8192, F.G, (int)blockIdx.x);
          pg8::EpiG E{Gb}; pg8::gemm_phase<pg8::EpiG, pg8::StaticOrder, true, true>(F.lds + RING_OFF, g, S, E); }
    }
    SEAM(5);
    if (IN(6)) {
        pg8::StaticOrder S; S.init(NTOK, DM, F.G, (int)blockIdx.x);
        { pg8::Gemm g{Qb, WOA, NTOK, DM, WA}; pg8::EpiM<false> E{Mb, Gb}; pg8::gemm_phase<pg8::EpiM<false>, pg8::StaticOrder, true, true>(F.lds + RING_OFF, g, S, E); }
        __syncthreads();
        { pg8::Gemm g{YBb, WOB, NTOK, DM, WA}; pg8::EpiM<true> E{Mb, Gb}; pg8::gemm_phase<pg8::EpiM<true>, pg8::StaticOrder, true, true>(F.lds + RING_OFF, g, S, E); }
    }
    SEAM(6);
    if (IN(7)) {
        pg8::Gemm g{Mb, WOUT, NTOK, DM, DM}; pg8::StaticOrder S; S.init(NTOK, DM, F.G, (int)blockIdx.x);
        pg8::EpiOut E{x_prompt, x_sample, Qb, PART};
        pg8::gemm_phase<pg8::EpiOut, pg8::StaticOrder, true, true>(F.lds + RING_OFF, g, S, E);
    }
    SEAM(7);
    if (IN(8)) {
        const bool poison = (hi - lo > 1) && (__hip_atomic_load((gu32*)((unsigned*)(F.ctl + CW_BAR) + XB_TMO), RLX_AGENT) != 0u);
        for (int row = gw; row < NTOK; row += NGW) {
            const float ss = wave_sum(PART[(size_t)row * 64 + F.lane]); float rs = 1.f / sqrtf(ss * (1.f / 4096.f) + 1e-6f);
            if (poison) rs = __builtin_nanf("");
            const GAS u32x4* pr = (const GAS u32x4*)(Qb + (size_t)row * DM) + F.lane; GAS f32x4* o = (GAS f32x4*)(args.out + (size_t)row * DM) + 2 * F.lane; const GAS f32x4* gg = (const GAS f32x4*)final_g + 2 * F.lane;
#pragma unroll
            for (int j = 0; j < 8; ++j) { const u32x4 v = pr[64 * j]; const f32x4 g0 = gg[128 * j], g1 = gg[128 * j + 1];
                o[128 * j] = (f32x4){pg8::bflo(v.x), pg8::bfhi(v.x), pg8::bflo(v.y), pg8::bfhi(v.y)} * rs * g0; o[128 * j + 1] = (f32x4){pg8::bflo(v.z), pg8::bfhi(v.z), pg8::bflo(v.w), pg8::bfhi(v.w)} * rs * g1; }
        }
    }
#undef IN
#undef SEAM
}

extern "C" void kernel_launch(void* const* d_in, const int* in_sizes, int n_in, void* d_out, int out_size, void* d_ws, size_t ws_size, hipStream_t stream) {
    static int grid = 0;
    if (grid == 0) {
        if (n_in != 24 || in_sizes[0] != 4 * SEQP * DM || out_size != NTOK * DM || ws_size < WS_END) { fprintf(stderr, "kernel_launch: unexpected shapes / workspace (n_in %d, ws %zu); nothing launched\n", n_in, ws_size); grid = -1; return; }
        int dev = 0, cus = 0, per_cu = 0;
        if (hipGetDevice(&dev) != hipSuccess || hipDeviceGetAttribute(&cus, hipDeviceAttributeMultiprocessorCount, dev) != hipSuccess) { grid = -1; return; }
        if (hipFuncSetAttribute((const void*)fwd_kernel, hipFuncAttributeMaxDynamicSharedMemorySize, LDS_BYTES) != hipSuccess) { fprintf(stderr, "kernel_launch: hipFuncSetAttribute failed\n"); grid = -1; return; }
        if (hipOccupancyMaxActiveBlocksPerMultiprocessor(&per_cu, (const void*)fwd_kernel, NWAVES * 64, LDS_BYTES) != hipSuccess || per_cu < 1) { fprintf(stderr, "kernel_launch: occupancy query says %d\n", per_cu); }
        (void)hipGetLastError();
        grid = cus;
    }
    if (grid < 0) return;
    if (hipMemsetAsync((char*)d_ws + WS_CTL, 0, CTL_ZERO_BYTES, stream) != hipSuccess) return;
    Args a{};
    for (int i = 0; i < 24; ++i) a.in[i] = (const float*)d_in[i];
    a.out = (float*)d_out; a.ws = (unsigned char*)d_ws;
#if MK_SINGLE
    a.ph_lo = 0; a.ph_hi = NPHASE;
    hipLaunchKernelGGL(fwd_kernel, dim3(grid), dim3(NWAVES * 64), LDS_BYTES, stream, a);
#else
    for (int p = 0; p < NPHASE; ++p) { a.ph_lo = p; a.ph_hi = p + 1; hipLaunchKernelGGL(fwd_kernel, dim3(grid), dim3(NWAVES * 64), LDS_BYTES, stream, a); }
#endif
}
```
